# Optimizing an MI355X kernel written in HIP

```python
import math
import jax, jax.numpy as jnp
from jax import lax
import numpy as np

D_MODEL = 1024
BATCH = 4
SEQ = 8192
DEPTH = 2

N_MIXERS = 2
N_RET = (DEPTH + 1) // 2
N_LRU = DEPTH // 2

RET_HEADS = D_MODEL // 256
RET_DK = 256
RET_DV = 2 * RET_DK
RET_QK_W = RET_HEADS * RET_DK
RET_V_W = RET_HEADS * RET_DV
RET_CHUNK = 128
ROPE_BASE = 10000.0

LRU_WIDTH = 1536
LRU_BLOCK = 256
LRU_BLOCKS = LRU_WIDTH // LRU_BLOCK
LRU_CONV = 4
LRU_C = 8.0

D_FF = ((8 * D_MODEL // 3 + 255) // 256) * 256

NORM_EPS = 1e-6

kernel_name = "hybrid_retention_rglru_sandwich"


def rms_norm(x, g):
    xf = x.astype(jnp.float32)
    y = xf * lax.rsqrt(jnp.mean(xf * xf, axis=-1, keepdims=True) + NORM_EPS)
    return (y * g.astype(jnp.float32)).astype(x.dtype)


def rope(x, pos):
    half = x.shape[-1] // 2
    inv = 1.0 / (ROPE_BASE ** (jnp.arange(half, dtype=jnp.float32) / half))
    ang = pos.astype(jnp.float32)[:, None] * inv[None, :]
    cos = jnp.cos(ang)[None, :, None, :]
    sin = jnp.sin(ang)[None, :, None, :]
    x1, x2 = x[..., :half], x[..., half:]
    return jnp.concatenate([x1 * cos - x2 * sin, x1 * sin + x2 * cos], axis=-1)


def retention_mixer(x, w_in, w_out):
    B, S, _ = x.shape
    H, DK, DV, C = RET_HEADS, RET_DK, RET_DV, RET_CHUNK
    N = S // C
    proj = x @ w_in
    q, k, v, g = jnp.split(proj, [RET_QK_W, 2 * RET_QK_W, 2 * RET_QK_W + RET_V_W], axis=-1)
    pos = jnp.arange(S)
    q = rope(q.reshape(B, S, H, DK).astype(jnp.float32), pos)
    k = rope(k.reshape(B, S, H, DK).astype(jnp.float32), pos) * (DK ** -0.5)
    v = v.reshape(B, S, H, DV).astype(jnp.float32)

    log_gamma = jnp.log1p(-jnp.exp2(-5.0 - jnp.arange(H, dtype=jnp.float32)))
    idx = jnp.arange(C, dtype=jnp.float32)
    rel = idx[:, None] - idx[None, :]
    causal = rel >= 0
    decay = jnp.where(causal[None],
                      jnp.exp(jnp.where(causal, rel, 0.0)[None] * log_gamma[:, None, None]),
                      0.0)
    q_decay = jnp.exp((idx[:, None] + 1.0) * log_gamma[None, :])
    k_decay = jnp.exp((C - 1.0 - idx[:, None]) * log_gamma[None, :])
    chunk_decay = jnp.exp(C * log_gamma)

    qc = q.reshape(B, N, C, H, DK)
    kc = k.reshape(B, N, C, H, DK)
    vc = v.reshape(B, N, C, H, DV)

    scores = jnp.einsum('bnqhd,bnkhd->bnhqk', qc, kc) * decay[None, None]
    intra = jnp.einsum('bnhqk,bnkhe->bnqhe', scores, vc)

    def step(state, inp):
        qi, ki, vi = inp
        out = jnp.einsum('bchd,bhde->bche', qi, state) * q_decay[None, :, :, None]
        state = state * chunk_decay[None, :, None, None] + jnp.einsum(
            'bchd,bche->bhde', ki * k_decay[None, :, :, None], vi)
        return state, out

    state0 = jnp.zeros((B, H, DK, DV), jnp.float32)
    _, inter = lax.scan(step, state0, (qc.transpose(1, 0, 2, 3, 4),
                                       kc.transpose(1, 0, 2, 3, 4),
                                       vc.transpose(1, 0, 2, 3, 4)))
    o = (intra + inter.transpose(1, 0, 2, 3, 4)).reshape(B, S, H, DV)

    mu = jnp.mean(o, axis=-1, keepdims=True)
    oc = o - mu
    o = oc * lax.rsqrt(jnp.mean(oc * oc, axis=-1, keepdims=True) + NORM_EPS)
    o = o.reshape(B, S, RET_V_W).astype(x.dtype) * jax.nn.silu(g)
    return o @ w_out


def rglru_mixer(x, w_in, conv_w, conv_b, gate_w, gate_b, a_param, w_out):
    B, S, _ = x.shape
    proj = x @ w_in
    y_branch, u = jnp.split(proj, 2, axis=-1)
    y_branch = jax.nn.gelu(y_branch, approximate=True)

    u = lax.conv_general_dilated(
        u, conv_w[:, None, :], window_strides=(1,), padding=[(LRU_CONV - 1, 0)],
        dimension_numbers=('NWC', 'WIO', 'NWC'), feature_group_count=LRU_WIDTH) + conv_b

    ub = u.reshape(B, S, LRU_BLOCKS, LRU_BLOCK)
    gates = jnp.einsum('bsnk,gnkj->gbsnj', ub, gate_w) + gate_b[:, None, None]
    gates = jax.nn.sigmoid(gates.astype(jnp.float32)).reshape(2, B, S, LRU_WIDTH)
    r, i = gates[0], gates[1]

    log_a = -LRU_C * r * jax.nn.softplus(-a_param.astype(jnp.float32))
    a = jnp.exp(log_a)
    mult = jnp.sqrt(-jnp.expm1(2.0 * log_a))
    b = mult * (i * u.astype(jnp.float32))

    def combine(lhs, rhs):
        a1, b1 = lhs
        a2, b2 = rhs
        return a1 * a2, a2 * b1 + b2

    _, h = lax.associative_scan(combine, (a, b), axis=1)
    return (h.astype(x.dtype) * y_branch) @ w_out


def swiglu_ffn(x, w_in, w_out):
    gate, up = jnp.split(x @ w_in, 2, axis=-1)
    return (jax.nn.silu(gate) * up) @ w_out


def setup_inputs(seed: int = 0) -> dict:
    key = jax.random.key(seed)
    ks = jax.random.split(key, 16)
    f32 = jnp.float32

    def normal(k, shape, fan_in):
        return jax.random.normal(k, shape, f32) * (fan_in ** -0.5)

    x = jax.random.normal(ks[0], (BATCH, SEQ, D_MODEL), f32)
    ret_w_in = normal(ks[1], (N_RET, D_MODEL, 2 * RET_QK_W + 2 * RET_V_W), D_MODEL)
    ret_w_out = normal(ks[2], (N_RET, RET_V_W, D_MODEL), RET_V_W)
    lru_w_in = normal(ks[3], (N_LRU, D_MODEL, 2 * LRU_WIDTH), D_MODEL)
    lru_conv_w = normal(ks[4], (N_LRU, LRU_CONV, LRU_WIDTH), LRU_CONV)
    lru_conv_b = 0.01 * jax.random.normal(ks[5], (N_LRU, LRU_WIDTH), f32)
    lru_gate_w = normal(ks[6], (N_LRU, 2, LRU_BLOCKS, LRU_BLOCK, LRU_BLOCK), LRU_BLOCK)
    lru_gate_b = 0.01 * jax.random.normal(ks[7], (N_LRU, 2, LRU_BLOCKS, LRU_BLOCK), f32)
    a0 = jax.random.uniform(ks[8], (N_LRU, LRU_WIDTH), f32, minval=0.9, maxval=0.999)
    lru_a_param = jnp.log(a0) - jnp.log1p(-a0)
    lru_w_out = normal(ks[9], (N_LRU, LRU_WIDTH, D_MODEL), LRU_WIDTH)
    norm_g = 1.0 + 0.02 * jax.random.normal(ks[10], (DEPTH, 4, D_MODEL), f32)
    ffn_w_in = normal(ks[11], (DEPTH, D_MODEL, 2 * D_FF), D_MODEL)
    ffn_w_out = normal(ks[12], (DEPTH, D_FF, D_MODEL), D_FF)
    return {"x": x, "ret_w_in": ret_w_in, "ret_w_out": ret_w_out,
            "lru_w_in": lru_w_in, "lru_conv_w": lru_conv_w, "lru_conv_b": lru_conv_b,
            "lru_gate_w": lru_gate_w, "lru_gate_b": lru_gate_b, "lru_a_param": lru_a_param,
            "lru_w_out": lru_w_out, "norm_g": norm_g,
            "ffn_w_in": ffn_w_in, "ffn_w_out": ffn_w_out}


def reference(x, ret_w_in, ret_w_out, lru_w_in, lru_conv_w, lru_conv_b, lru_gate_w,
              lru_gate_b, lru_a_param, lru_w_out, norm_g, ffn_w_in, ffn_w_out):
    for layer in range(DEPTH):
        j = layer // N_MIXERS
        h = rms_norm(x, norm_g[layer, 0])
        if layer % N_MIXERS == 0:
            m = retention_mixer(h, ret_w_in[j], ret_w_out[j])
        else:
            m = rglru_mixer(h, lru_w_in[j], lru_conv_w[j], lru_conv_b[j], lru_gate_w[j],
                            lru_gate_b[j], lru_a_param[j], lru_w_out[j])
        x = x + rms_norm(m, norm_g[layer, 1])
        f = swiglu_ffn(rms_norm(x, norm_g[layer, 2]), ffn_w_in[layer], ffn_w_out[layer])
        x = x + rms_norm(f, norm_g[layer, 3])
    return x
```

```cpp
#include <hip/hip_runtime.h>
#include <hip/hip_cooperative_groups.h>
#include <cstdio>
#include <cstdint>
namespace cg = cooperative_groups;

#ifndef MK_MULTI
#define MK_MULTI 0
#endif

#define LAS __attribute__((address_space(3)))
typedef unsigned short bf16_t;
typedef short bf16x8 __attribute__((ext_vector_type(8)));
typedef short s16x4 __attribute__((ext_vector_type(4)));
typedef float f32x4 __attribute__((ext_vector_type(4)));
typedef float f32x2 __attribute__((ext_vector_type(2)));
typedef unsigned u32x4 __attribute__((ext_vector_type(4)));
typedef unsigned u32x2 __attribute__((ext_vector_type(2)));

constexpr int MTOK = 32768, SEQ = 8192, DM = 1024;
constexpr int DFF = 2816, LW = 1536;
constexpr float EPS = 1e-6f;
constexpr size_t MiB = 1u << 20;
constexpr int LDH = 1088;
constexpr int LDW = 1024;
constexpr size_t WS_WRIN = 0, WS_WROUT = 12 * MiB, WS_WLIN = 16 * MiB, WS_WG = 22 * MiB, WS_WLOUT = 23 * MiB + MiB / 2,
                 WS_WFIN = 26 * MiB + MiB / 2, WS_WFOUT = 48 * MiB + MiB / 2;
constexpr size_t WS_SCAN = 59 * MiB + MiB / 2;
constexpr size_t WS_H = 60 * MiB;
static_assert(WS_H + (size_t)32768 * LDH * 2 <= 128 * MiB, "d_ws map");
constexpr size_t WS_Q = 128 * MiB, WS_K = 192 * MiB, WS_V = 256 * MiB, WS_G = 384 * MiB;
constexpr size_t WS_HID0 = 128 * MiB;
constexpr size_t WS_Y = 128 * MiB, WS_U = 224 * MiB, WS_UC = 320 * MiB, WS_B = 416 * MiB;
constexpr size_t WS_HID1 = 224 * MiB;
constexpr size_t WS_NEED = 512 * MiB;
constexpr int LDS_BYTES = 147456;
constexpr int NPHASE = 19;

__device__ __forceinline__ unsigned cvt_pk_bf16(float lo, float hi) { unsigned r; asm volatile("v_cvt_pk_bf16_f32 %0, %1, %2" : "=v"(r) : "v"(lo), "v"(hi)); return r; }
__device__ __forceinline__ float bf_lo(unsigned w) { return __uint_as_float(w << 16); }
__device__ __forceinline__ float bf_hi(unsigned w) { return __uint_as_float(w & 0xffff0000u); }
__device__ __forceinline__ void store8(bf16_t* p, f32x4 v0, f32x4 v1) {
    u32x4 w; w.x = cvt_pk_bf16(v0[0], v0[1]); w.y = cvt_pk_bf16(v0[2], v0[3]); w.z = cvt_pk_bf16(v1[0], v1[1]); w.w = cvt_pk_bf16(v1[2], v1[3]);
    *(u32x4*)p = w;
}
__device__ __forceinline__ float wave_sum(float v) {
#pragma unroll
    for (int o = 1; o < 64; o <<= 1) v += __shfl_xor(v, o);
    return v;
}
__device__ __forceinline__ int lane_id_fresh() { return (int)__builtin_amdgcn_mbcnt_hi(~0u, __builtin_amdgcn_mbcnt_lo(~0u, 0u)); }
__device__ __forceinline__ float sigmoidf_(float x) { return __builtin_amdgcn_rcpf(1.0f + __builtin_amdgcn_exp2f(-1.4426950408889634f * x)); }

namespace pg8 {
constexpr int BM = 256, BK = 64, HALF = 128, HTB = HALF * BK * 2, STAGE_BYTES = 8 * HTB, NXCD = 8, WGM = 8;
__host__ __device__ __forceinline__ int lds_byte(int r, int c) { const int st = (r >> 4) * 2 + (c >> 5), rr = r & 15, cc = c & 31, ob = rr * 64 + cc * 2; return st * 1024 + (ob ^ (((ob >> 9) & 1) << 5)); }
__host__ __device__ __forceinline__ void stage_rc(int b, int& R, int& C) { const int st = b / 1024, sb = b % 1024, swz = sb ^ (((sb >> 9) & 1) << 5); R = (st >> 1) * 16 + swz / 64; C = (st & 1) * 32 + (swz % 64) / 2; }
__host__ __device__ __forceinline__ int perm32(int rho) { const int n = rho >> 4, i = rho & 15; return 8 * (i >> 2) + 4 * n + (i & 3); }

struct Unit { int pm, pn; };
struct Gemm { const bf16_t* A; const bf16_t* Bt; int M, N, K, lda, ldb, npg; size_t goffA; };

struct StaticOrder {
    int nM, nN, nwg, G, c;
    __host__ __device__ void init(int M, int N, int G_, int c_) { nM = M / BM; nN = N / BM; nwg = nM * nN; G = G_; c = c_; }
    __host__ __device__ bool next(int i, Unit& u) const {
        const long L = (long)i * G + c; if (L >= nwg) return false;
        int wgid = (int)L; { const int q = nwg / NXCD, r = nwg % NXCD, xcd = wgid % NXCD, off = wgid / NXCD; wgid = (xcd < r ? xcd * (q + 1) : r * (q + 1) + (xcd - r) * q) + off; }
        const int nig = WGM * nN, gid = wgid / nig, fm = gid * WGM, gsz = (nM - fm) < WGM ? (nM - fm) : WGM;
        u.pm = fm + ((wgid % nig) % gsz); u.pn = (wgid % nig) / gsz; return true;
    }
};

template <class Epi, bool ALIGN_EPI = true, bool SP2 = true>
__device__ __forceinline__ void gemm_phase(LAS unsigned char* lds, const Gemm g, const StaticOrder& S, const Epi& E, unsigned stagger_ticks = 0) {
    if (stagger_ticks) {
        const unsigned long long t0 = __builtin_amdgcn_s_memrealtime(); const unsigned long long wait = (unsigned long long)(((unsigned)__builtin_amdgcn_s_getreg((3 << 11) | 20) & 7u) * stagger_ticks);
        while (__builtin_amdgcn_s_memrealtime() - t0 < wait) __builtin_amdgcn_s_sleep(8);
    }
    const int tid = threadIdx.x, wid = __builtin_amdgcn_readfirstlane(tid >> 6), lane = tid & 63, wr = wid >> 2, wc = wid & 3, fr = lane & 15, fq = lane >> 4;
    const int K = g.K, nt = K / BK;
    unsigned voffA[2], voffB[2];
#pragma unroll
    for (int i = 0; i < 2; ++i) { int R, C; stage_rc(tid * 16 + i * 8192, R, C); const int Rb = (R & ~31) + perm32(R & 31);
        voffA[i] = (unsigned)(R * g.lda + C) * 2u; voffB[i] = (unsigned)(Rb * g.ldb + C) * 2u; }
    const size_t kstep = (size_t)(BK * 2);
    const size_t hstepA = (size_t)HALF * g.lda * 2, hstepB = (size_t)HALF * g.ldb * 2;
    const size_t tstepA = 2 * hstepA, tstepB = 2 * hstepB;
    const unsigned ldsw = (unsigned)wid * 1024u;
    const int aoff = lds_byte(wr * 64 + fr, fq * 8), boff = lds_byte(wc * 32 + fr, fq * 8);
#define PG8_SA(b, h) (((b) * 2 + (h)) * HTB)
#define PG8_SB(b, h) ((4 + (b) * 2 + (h)) * HTB)
#define PG8_STAGE(bufoff, gbase, voff) do { _Pragma("unroll") for (int _i = 0; _i < 2; ++_i) \
        __builtin_amdgcn_global_load_lds((const unsigned*)((const char*)(gbase) + (voff)[_i]), (LAS unsigned*)(lds + (bufoff) + ldsw + _i * 8192), 16, 0, 0); } while (0)
#define PG8_LDA(dst, b, h) do { _Pragma("unroll") for (int m = 0; m < 4; ++m) _Pragma("unroll") for (int k = 0; k < 2; ++k) dst[m][k] = *(const LAS bf16x8*)(lds + PG8_SA(b, h) + aoff + m * 2048 + k * 1024); } while (0)
#define PG8_LDB(dst, b, h) do { _Pragma("unroll") for (int n = 0; n < 2; ++n) _Pragma("unroll") for (int k = 0; k < 2; ++k) dst[n][k] = *(const LAS bf16x8*)(lds + PG8_SB(b, h) + boff + n * 2048 + k * 1024); } while (0)
#define PG8_MMA(ai, bj, At, Bt) do { __builtin_amdgcn_s_setprio(1); _Pragma("unroll") for (int m = 0; m < 4; ++m) _Pragma("unroll") for (int n = 0; n < 2; ++n) _Pragma("unroll") for (int k = 0; k < 2; ++k) \
        acc[ai][bj][m][n] = __builtin_amdgcn_mfma_f32_16x16x32_bf16(Bt[n][k], At[m][k], acc[ai][bj][m][n], 0, 0, 0); __builtin_amdgcn_s_setprio(0); } while (0)
#define PG8_WAIT_V(n) asm volatile("s_waitcnt vmcnt(" #n ")" ::: "memory")
#define PG8_WAIT_L(n) asm volatile("s_waitcnt lgkmcnt(" #n ")" ::: "memory")
#define PG8_BAR __builtin_amdgcn_s_barrier()
#define PG8_SCHED __builtin_amdgcn_sched_barrier(0)
#define PG8_APTR(u) ((const char*)g.A + (size_t)(u).pm * tstepA + (size_t)((u).pn / g.npg) * g.goffA)
#define PG8_BPTR(u) ((const char*)g.Bt + (size_t)(u).pn * tstepB)
    Unit cur, nxt; int ui = 0;
    if (!S.next(0, cur)) return;
    f32x4 acc[2][2][4][2];
#pragma unroll
    for (int a = 0; a < 2; ++a)
#pragma unroll
        for (int b = 0; b < 2; ++b)
#pragma unroll
            for (int m = 0; m < 4; ++m)
#pragma unroll
                for (int n = 0; n < 2; ++n) acc[a][b][m][n] = (f32x4){0.f, 0.f, 0.f, 0.f};
    bf16x8 At[4][2], B0[2][2], B1[2][2];
    const char* cA = PG8_APTR(cur); const char* cB = PG8_BPTR(cur);
    if constexpr (SP2) {
        PG8_STAGE(PG8_SB(0, 0), cB, voffB); PG8_STAGE(PG8_SB(0, 1), cB + hstepB, voffB); PG8_STAGE(PG8_SA(0, 0), cA, voffA); PG8_STAGE(PG8_SA(0, 1), cA + hstepA, voffA);
        if (wr == 1) PG8_BAR;
        PG8_WAIT_V(2); PG8_BAR;
        PG8_STAGE(PG8_SB(1, 0), cB + kstep, voffB); PG8_STAGE(PG8_SA(1, 0), cA + kstep, voffA); PG8_STAGE(PG8_SB(1, 1), cB + hstepB + kstep, voffB);
        PG8_WAIT_V(6); PG8_BAR;
    } else {
        PG8_STAGE(PG8_SB(0, 0), cB, voffB); PG8_STAGE(PG8_SA(0, 0), cA, voffA); PG8_STAGE(PG8_SB(0, 1), cB + hstepB, voffB); PG8_STAGE(PG8_SA(0, 1), cA + hstepA, voffA);
        if (wr == 1) PG8_BAR;
        PG8_WAIT_V(4); PG8_BAR;
        PG8_STAGE(PG8_SB(1, 0), cB + kstep, voffB); PG8_STAGE(PG8_SA(1, 0), cA + kstep, voffA); PG8_STAGE(PG8_SB(1, 1), cB + hstepB + kstep, voffB);
        PG8_WAIT_V(6); PG8_BAR;
    }
    for (;;) {
        const bool has_next = S.next(ui + 1, nxt);
        const char* nA = has_next ? PG8_APTR(nxt) : cA; const char* nB = has_next ? PG8_BPTR(nxt) : cB;
        for (int t = 0; t < nt; t += 2) {
            const bool last = (t == nt - 2);
            const char* a1 = cA + (size_t)(t + 1) * kstep;
            const char* a2 = last ? nA : cA + (size_t)(t + 2) * kstep; const char* b2 = last ? nB : cB + (size_t)(t + 2) * kstep;
            const char* a3 = a2 + kstep; const char* b3 = b2 + kstep;
            if constexpr (SP2) {
            PG8_LDB(B0, 0, 0); PG8_LDB(B1, 0, 1); PG8_SCHED; PG8_LDA(At, 0, 0); PG8_STAGE(PG8_SA(1, 1), a1 + hstepA, voffA);
            PG8_WAIT_V(8); PG8_WAIT_L(0); PG8_BAR; PG8_MMA(0, 0, At, B0); PG8_MMA(0, 1, At, B1); PG8_BAR; PG8_SCHED;
            PG8_LDA(At, 0, 1); PG8_STAGE(PG8_SB(0, 0), b2, voffB); PG8_STAGE(PG8_SB(0, 1), b2 + hstepB, voffB); PG8_STAGE(PG8_SA(0, 0), a2, voffA);
            PG8_WAIT_V(8); PG8_WAIT_L(0); PG8_BAR; PG8_MMA(1, 0, At, B0); PG8_MMA(1, 1, At, B1); PG8_BAR; PG8_SCHED;
            PG8_LDB(B0, 1, 0); PG8_LDB(B1, 1, 1); PG8_SCHED; PG8_LDA(At, 1, 0); PG8_STAGE(PG8_SA(0, 1), a2 + hstepA, voffA);
            PG8_WAIT_V(8); PG8_WAIT_L(0); PG8_BAR; PG8_MMA(0, 0, At, B0); PG8_MMA(0, 1, At, B1); PG8_BAR; PG8_SCHED;
            PG8_LDA(At, 1, 1); PG8_STAGE(PG8_SB(1, 0), b3, voffB); PG8_STAGE(PG8_SB(1, 1), b3 + hstepB, voffB); PG8_STAGE(PG8_SA(1, 0), a3, voffA);
            PG8_WAIT_V(8); PG8_WAIT_L(0); PG8_BAR; PG8_MMA(1, 0, At, B0); PG8_MMA(1, 1, At, B1); PG8_BAR; PG8_SCHED;
            } else {
            PG8_LDB(B0, 0, 0); PG8_SCHED; PG8_LDA(At, 0, 0); PG8_STAGE(PG8_SA(1, 1), a1 + hstepA, voffA);
            PG8_WAIT_L(8); PG8_BAR; PG8_WAIT_L(0); PG8_MMA(0, 0, At, B0); PG8_BAR; PG8_SCHED;
            PG8_LDB(B1, 0, 1); PG8_STAGE(PG8_SB(0, 0), b2, voffB);
            PG8_BAR; PG8_WAIT_L(0); PG8_MMA(0, 1, At, B1); PG8_BAR;
            PG8_LDA(At, 0, 1); PG8_STAGE(PG8_SA(0, 0), a2, voffA);
            PG8_BAR; PG8_WAIT_L(0); PG8_MMA(1, 0, At, B0); PG8_BAR; PG8_SCHED;
            PG8_STAGE(PG8_SB(0, 1), b2 + hstepB, voffB);
            PG8_WAIT_V(6); PG8_BAR; PG8_MMA(1, 1, At, B1); PG8_BAR;
            PG8_LDB(B0, 1, 0); PG8_SCHED; PG8_LDA(At, 1, 0); PG8_STAGE(PG8_SA(0, 1), a2 + hstepA, voffA);
            PG8_WAIT_L(8); PG8_BAR; PG8_WAIT_L(0); PG8_MMA(0, 0, At, B0); PG8_BAR; PG8_SCHED;
            PG8_LDB(B1, 1, 1); PG8_STAGE(PG8_SB(1, 0), b3, voffB);
            PG8_BAR; PG8_WAIT_L(0); PG8_MMA(0, 1, At, B1); PG8_BAR;
            PG8_LDA(At, 1, 1); PG8_STAGE(PG8_SA(1, 0), a3, voffA);
            PG8_BAR; PG8_WAIT_L(0); PG8_MMA(1, 0, At, B0); PG8_BAR; PG8_SCHED;
            PG8_STAGE(PG8_SB(1, 1), b3 + hstepB, voffB);
            PG8_WAIT_V(6); PG8_BAR; PG8_MMA(1, 1, At, B1); PG8_BAR;
            }
        }
        if constexpr (ALIGN_EPI) { if (wr == 0) PG8_BAR; }
        E(acc, cur, wr, wc, fr, fq);
        if (!has_next) break;
#pragma unroll
        for (int a = 0; a < 2; ++a)
#pragma unroll
            for (int b = 0; b < 2; ++b)
#pragma unroll
                for (int m = 0; m < 4; ++m)
#pragma unroll
                    for (int n = 0; n < 2; ++n) acc[a][b][m][n] = (f32x4){0.f, 0.f, 0.f, 0.f};
        cur = nxt; cA = nA; cB = nB; ++ui;
        if constexpr (ALIGN_EPI) { if (wr == 1) PG8_BAR; }
    }
    PG8_WAIT_V(0);
    if constexpr (!ALIGN_EPI) { if (wr == 0) PG8_BAR; }
    PG8_BAR;
#undef PG8_SA
#undef PG8_SB
#undef PG8_STAGE
#undef PG8_LDA
#undef PG8_LDB
#undef PG8_MMA
#undef PG8_WAIT_V
#undef PG8_WAIT_L
#undef PG8_BAR
#undef PG8_SCHED
#undef PG8_APTR
#undef PG8_BPTR
}
}
typedef f32x4 Acc[2][2][4][2];

struct EpiPlain {
    bf16_t* O; int ldc;
    __device__ __forceinline__ void operator()(const Acc& acc, const pg8::Unit& u, int wr, int wc, int fr, int fq) const {
        const int row0 = u.pm * 256 + wr * 64 + fr, col0 = u.pn * 256 + wc * 32 + 8 * fq;
#pragma unroll
        for (int ai = 0; ai < 2; ++ai)
#pragma unroll
            for (int m = 0; m < 4; ++m) { bf16_t* rowp = O + (size_t)(row0 + ai * 128 + m * 16) * ldc + col0;
#pragma unroll
                for (int bj = 0; bj < 2; ++bj) store8(rowp + bj * 128, acc[ai][bj][m][0], acc[ai][bj][m][1]); }
    }
};
struct EpiRetIn {
    bf16_t *Q, *K, *V, *G;
    __device__ __forceinline__ void operator()(const Acc& acc, const pg8::Unit& u, int wr, int wc, int fr, int fq) const {
        const int row0 = u.pm * 256 + wr * 64 + fr, cl = wc * 32 + 8 * fq;
        if (u.pn < 8) {
            const int head = u.pn & 3; bf16_t* dst = (u.pn < 4 ? Q : K) + head * 256 + cl; const float sc = u.pn < 4 ? 1.0f : 0.0625f;
            float inv[2][4];
#pragma unroll
            for (int n = 0; n < 2; ++n)
#pragma unroll
                for (int j = 0; j < 4; ++j) inv[n][j] = __builtin_amdgcn_exp2f(-(float)(cl + 4 * n + j) * 0.10381025296523f);
#pragma unroll
            for (int ai = 0; ai < 2; ++ai)
#pragma unroll
                for (int m = 0; m < 4; ++m) { const int row = row0 + ai * 128 + m * 16; const float pos = (float)(row & (SEQ - 1));
                    f32x4 o1[2], o2[2];
#pragma unroll
                    for (int n = 0; n < 2; ++n)
#pragma unroll
                        for (int j = 0; j < 4; ++j) { float t = (pos * inv[n][j]) * 0.15915494309189535f; t = t - floorf(t);
                            const float s = __builtin_amdgcn_sinf(t), c = __builtin_amdgcn_cosf(t);
                            const float x1 = acc[ai][0][m][n][j], x2 = acc[ai][1][m][n][j];
                            o1[n][j] = (x1 * c - x2 * s) * sc; o2[n][j] = (x1 * s + x2 * c) * sc; }
                    bf16_t* rowp = dst + (size_t)row * 1024;
                    store8(rowp, o1[0], o1[1]); store8(rowp + 128, o2[0], o2[1]); }
        } else if (u.pn < 16) {
            bf16_t* dst = V + (u.pn - 8) * 256 + cl;
#pragma unroll
            for (int ai = 0; ai < 2; ++ai)
#pragma unroll
                for (int m = 0; m < 4; ++m) { bf16_t* rowp = dst + (size_t)(row0 + ai * 128 + m * 16) * 2048;
#pragma unroll
                    for (int bj = 0; bj < 2; ++bj) store8(rowp + bj * 128, acc[ai][bj][m][0], acc[ai][bj][m][1]); }
        } else {
            bf16_t* dst = G + (u.pn - 16) * 256 + cl;
#pragma unroll
            for (int ai = 0; ai < 2; ++ai)
#pragma unroll
                for (int m = 0; m < 4; ++m) { bf16_t* rowp = dst + (size_t)(row0 + ai * 128 + m * 16) * 2048;
#pragma unroll
                    for (int bj = 0; bj < 2; ++bj) store8(rowp + bj * 128, acc[ai][bj][m][0], acc[ai][bj][m][1]); }
        }
    }
};
struct EpiNull {
    bf16_t* O;
    __device__ __forceinline__ void operator()(const Acc& acc, const pg8::Unit& u, int wr, int wc, int fr, int fq) const {
        float s = 0.f;
#pragma unroll
        for (int ai = 0; ai < 2; ++ai)
#pragma unroll
            for (int bj = 0; bj < 2; ++bj)
#pragma unroll
                for (int m = 0; m < 4; ++m)
#pragma unroll
                    for (int n = 0; n < 2; ++n) s += acc[ai][bj][m][n][0] + acc[ai][bj][m][n][1] + acc[ai][bj][m][n][2] + acc[ai][bj][m][n][3];
        if (s == 1.2345678e-30f) O[u.pm + wr + wc + fr + fq] = 1;
    }
};
struct EpiSwiglu {
    bf16_t* Hd;
    __device__ __forceinline__ void operator()(const Acc& acc, const pg8::Unit& u, int wr, int wc, int fr, int fq) const {
        const int row0 = u.pm * 256 + wr * 64 + fr, col0 = u.pn * 128 + wc * 32 + 8 * fq;
#pragma unroll
        for (int ai = 0; ai < 2; ++ai)
#pragma unroll
            for (int m = 0; m < 4; ++m) { f32x4 v[2];
#pragma unroll
                for (int n = 0; n < 2; ++n)
#pragma unroll
                    for (int j = 0; j < 4; ++j) { const float gt = acc[ai][0][m][n][j]; v[n][j] = gt * sigmoidf_(gt) * acc[ai][1][m][n][j]; }
                store8(Hd + (size_t)(row0 + ai * 128 + m * 16) * DFF + col0, v[0], v[1]); }
    }
};
struct EpiLruIn {
    bf16_t *Y, *U;
    __device__ __forceinline__ void operator()(const Acc& acc, const pg8::Unit& u, int wr, int wc, int fr, int fq) const {
        const int row0 = u.pm * 256 + wr * 64 + fr; const bool isy = u.pn < 6;
        bf16_t* dst = (isy ? Y : U) + (isy ? u.pn : u.pn - 6) * 256 + wc * 32 + 8 * fq;
#pragma unroll
        for (int ai = 0; ai < 2; ++ai)
#pragma unroll
            for (int m = 0; m < 4; ++m) { bf16_t* rowp = dst + (size_t)(row0 + ai * 128 + m * 16) * LW;
#pragma unroll
                for (int bj = 0; bj < 2; ++bj) store8(rowp + bj * 128, acc[ai][bj][m][0], acc[ai][bj][m][1]); }
    }
};
struct EpiGates {
    const bf16_t* UC; const float* gate_b; const float* a_param; bf16_t* LA; bf16_t* Bo;
    __device__ __forceinline__ void operator()(const Acc& acc, const pg8::Unit& u, int wr, int wc, int fr, int fq) const {
        const int row0 = u.pm * 256 + wr * 64 + fr, blk = u.pn >> 1, t = u.pn & 1;
#pragma unroll
        for (int n = 0; n < 2; ++n) {
            const int cloc = 128 * t + wc * 32 + 8 * fq + 4 * n, ch0 = 256 * blk + cloc;
            const f32x4 br = *(const f32x4*)(gate_b + blk * 256 + cloc), bi = *(const f32x4*)(gate_b + (6 + blk) * 256 + cloc), ap = *(const f32x4*)(a_param + ch0);
            f32x4 sp;
#pragma unroll
            for (int j = 0; j < 4; ++j) sp[j] = -8.0f * log1pf(__expf(-ap[j]));
#pragma unroll
            for (int ai = 0; ai < 2; ++ai)
#pragma unroll
                for (int m = 0; m < 4; ++m) { const size_t off = (size_t)(row0 + ai * 128 + m * 16) * LW + ch0;
                    const u32x2 uw = *(const u32x2*)(UC + off);
                    const float uc[4] = {bf_lo(uw.x), bf_hi(uw.x), bf_lo(uw.y), bf_hi(uw.y)};
                    float la[4], bb[4];
#pragma unroll
                    for (int j = 0; j < 4; ++j) {
                        const float r = sigmoidf_(acc[ai][0][m][n][j] + br[j]), ig = sigmoidf_(acc[ai][1][m][n][j] + bi[j]);
                        const float l = r * sp[j]; const float mult = sqrtf(fmaxf(1.0f - __expf(2.0f * l), 0.0f));
                        la[j] = l; bb[j] = mult * ig * uc[j]; }
                    u32x2 o1, o2; o1.x = cvt_pk_bf16(la[0], la[1]); o1.y = cvt_pk_bf16(la[2], la[3]); o2.x = cvt_pk_bf16(bb[0], bb[1]); o2.y = cvt_pk_bf16(bb[2], bb[3]);
                    *(u32x2*)(LA + off) = o1; *(u32x2*)(Bo + off) = o2; }
        }
    }
};

__device__ __forceinline__ void transpose_item(const float* W, int ldw, int k0, int n0, bf16_t* WT, int ldt, int drow0, LAS float* scr, int lane) {
#pragma unroll 8
    for (int i = 0; i < 32; ++i) { const int kk = 2 * i + (lane >> 5); scr[kk * 33 + (lane & 31)] = W[(size_t)(k0 + kk) * ldw + n0 + (lane & 31)]; }
    asm volatile("s_waitcnt lgkmcnt(0)" ::: "memory");
    const int c = lane & 7;
#pragma unroll
    for (int j = 0; j < 4; ++j) { const int n = (lane >> 3) + 8 * j; const LAS float* s = scr + (8 * c) * 33 + n;
        u32x4 o; o.x = cvt_pk_bf16(s[0 * 33], s[1 * 33]); o.y = cvt_pk_bf16(s[2 * 33], s[3 * 33]); o.z = cvt_pk_bf16(s[4 * 33], s[5 * 33]); o.w = cvt_pk_bf16(s[6 * 33], s[7 * 33]);
        *(u32x4*)(WT + (size_t)(drow0 + n) * ldt + k0 + 8 * c) = o; }
    asm volatile("s_waitcnt lgkmcnt(0)" ::: "memory");
}
__device__ __forceinline__ void rms_row_to_bf16(const float* xr, const float* g, bf16_t* orow, int lane) {
    f32x4 v[4]; float s = 0.f;
#pragma unroll
    for (int j = 0; j < 4; ++j) { v[j] = *(const f32x4*)(xr + 256 * j + 4 * lane); s += (v[j][0] * v[j][0] + v[j][1] * v[j][1]) + (v[j][2] * v[j][2] + v[j][3] * v[j][3]); }
    const float rstd = rsqrtf(wave_sum(s) * (1.0f / DM) + EPS);
#pragma unroll
    for (int j = 0; j < 4; ++j) { const f32x4 gg = *(const f32x4*)(g + 256 * j + 4 * lane);
        u32x2 w; w.x = cvt_pk_bf16(v[j][0] * rstd * gg[0], v[j][1] * rstd * gg[1]); w.y = cvt_pk_bf16(v[j][2] * rstd * gg[2], v[j][3] * rstd * gg[3]);
        *(u32x2*)(orow + 256 * j + 4 * lane) = w; }
}

struct Args {
    const float* in[13]; float* out; unsigned char* ws; int ph_lo, ph_hi, coop, pad;
};

__device__ __forceinline__ void phase_prologue(const Args& a, LAS unsigned char* lds, int gw, int NGW, int wave, int lane) {
    LAS float* scr = (LAS float*)(lds + wave * 16384);
    unsigned char* ws = a.ws;
    const float* ret_w_in = a.in[1]; const float* ret_w_out = a.in[2]; const float* lru_w_in = a.in[3]; const float* gate_w = a.in[6];
    const float* lru_w_out = a.in[9]; const float* ffn_w_in = a.in[11]; const float* ffn_w_out = a.in[12];
    constexpr int I0 = 16 * 192, I1 = 32 * 32, I2 = 16 * 96, I3 = 12 * 32, I4 = 24 * 32, I5 = 16 * 176, I6 = 44 * 32;
    constexpr int NITEMS = I0 + I1 + I2 + I3 + I4 + 2 * I5 + 2 * I6;
    for (int it = gw; it < NITEMS; it += NGW) {
        int r = it;
        if (r < I0) { const int kb = r / 192, nb = r % 192; transpose_item(ret_w_in, 6144, 64 * kb, 32 * nb, (bf16_t*)(ws + WS_WRIN), LDW, 32 * nb, scr, lane); continue; } r -= I0;
        if (r < I1) { const int kb = r / 32, nb = r % 32; transpose_item(ret_w_out, 1024, 64 * kb, 32 * nb, (bf16_t*)(ws + WS_WROUT), 2048, 32 * nb, scr, lane); continue; } r -= I1;
        if (r < I2) { const int kb = r / 96, nb = r % 96; transpose_item(lru_w_in, 3072, 64 * kb, 32 * nb, (bf16_t*)(ws + WS_WLIN), LDW, 32 * nb, scr, lane); continue; } r -= I2;
        if (r < I3) { const int mat = r / 32, q = r % 32, kb = q / 8, nb = q % 8, gg = mat / 6, blk = mat % 6, n0 = 32 * nb;
            transpose_item(gate_w + (size_t)mat * 65536, 256, 64 * kb, n0, (bf16_t*)(ws + WS_WG), 256, (2 * blk + n0 / 128) * 256 + 128 * gg + (n0 % 128), scr, lane); continue; } r -= I3;
        if (r < I4) { const int kb = r / 32, nb = r % 32; transpose_item(lru_w_out, 1024, 64 * kb, 32 * nb, (bf16_t*)(ws + WS_WLOUT), 1536, 32 * nb, scr, lane); continue; } r -= I4;
        if (r < 2 * I5) { const int l = r / I5, q = r % I5, kb = q / 176, nb = q % 176, n0 = 32 * nb; const int up = n0 >= DFF, c = up ? n0 - DFF : n0;
            transpose_item(ffn_w_in + (size_t)l * 1024 * 5632, 5632, 64 * kb, n0, (bf16_t*)(ws + WS_WFIN) + (size_t)l * 5632 * LDW, LDW, 256 * (c / 128) + 128 * up + (c % 128), scr, lane); continue; } r -= 2 * I5;
        { const int l = r / I6, q = r % I6, kb = q / 32, nb = q % 32;
            transpose_item(ffn_w_out + (size_t)l * DFF * 1024, 1024, 64 * kb, 32 * nb, (bf16_t*)(ws + WS_WFOUT) + (size_t)l * 1024 * DFF, DFF, 32 * nb, scr, lane); }
    }
    const float* x = a.in[0]; const float* ng = a.in[10]; bf16_t* H = (bf16_t*)(ws + WS_H);
    for (int m = gw; m < MTOK; m += NGW) rms_row_to_bf16(x + (size_t)m * DM, ng, H + (size_t)m * LDH, lane);
}

__device__ __forceinline__ void phase_norm_res(const float* xold, const bf16_t* Mb, const float* gpost, const float* gnext, float* out, bf16_t* H, int gw, int NGW, int lane) {
    for (int r0 = gw; r0 < MTOK; r0 += 2 * NGW) {
        float mv[2][16], xv[2][16];
#pragma unroll
        for (int q = 0; q < 2; ++q) { const int r = r0 + q * NGW; const bf16_t* mr = Mb + (size_t)r * LDH; const float* xr = xold + (size_t)r * DM;
#pragma unroll
            for (int h = 0; h < 2; ++h) { const u32x4 w = *(const u32x4*)(mr + 512 * h + 8 * lane);
                mv[q][8 * h + 0] = bf_lo(w.x); mv[q][8 * h + 1] = bf_hi(w.x); mv[q][8 * h + 2] = bf_lo(w.y); mv[q][8 * h + 3] = bf_hi(w.y);
                mv[q][8 * h + 4] = bf_lo(w.z); mv[q][8 * h + 5] = bf_hi(w.z); mv[q][8 * h + 6] = bf_lo(w.w); mv[q][8 * h + 7] = bf_hi(w.w);
                const f32x4 x0 = *(const f32x4*)(xr + 512 * h + 8 * lane), x1 = *(const f32x4*)(xr + 512 * h + 8 * lane + 4);
#pragma unroll
                for (int j = 0; j < 4; ++j) { xv[q][8 * h + j] = x0[j]; xv[q][8 * h + 4 + j] = x1[j]; } } }
        f32x4 gp[4];
#pragma unroll
        for (int h = 0; h < 2; ++h) { gp[2 * h] = *(const f32x4*)(gpost + 512 * h + 8 * lane); gp[2 * h + 1] = *(const f32x4*)(gpost + 512 * h + 8 * lane + 4); }
        float rs2[2];
#pragma unroll
        for (int q = 0; q < 2; ++q) { const int r = r0 + q * NGW; float* orow = out + (size_t)r * DM;
            float s = 0.f;
#pragma unroll
            for (int k = 0; k < 16; ++k) s += mv[q][k] * mv[q][k];
            const float rstd = rsqrtf(wave_sum(s) * (1.0f / DM) + EPS);
            float s2 = 0.f;
#pragma unroll
            for (int h = 0; h < 2; ++h) {
#pragma unroll
                for (int j = 0; j < 4; ++j) { xv[q][8 * h + j] += mv[q][8 * h + j] * rstd * gp[2 * h][j]; xv[q][8 * h + 4 + j] += mv[q][8 * h + 4 + j] * rstd * gp[2 * h + 1][j]; }
                *(f32x4*)(orow + 512 * h + 8 * lane) = (f32x4){xv[q][8 * h], xv[q][8 * h + 1], xv[q][8 * h + 2], xv[q][8 * h + 3]};
                *(f32x4*)(orow + 512 * h + 8 * lane + 4) = (f32x4){xv[q][8 * h + 4], xv[q][8 * h + 5], xv[q][8 * h + 6], xv[q][8 * h + 7]}; }
#pragma unroll
            for (int k = 0; k < 16; ++k) s2 += xv[q][k] * xv[q][k];
            rs2[q] = s2; }
        if (gnext) {
            f32x4 gn[4];
#pragma unroll
            for (int h = 0; h < 2; ++h) { gn[2 * h] = *(const f32x4*)(gnext + 512 * h + 8 * lane); gn[2 * h + 1] = *(const f32x4*)(gnext + 512 * h + 8 * lane + 4); }
#pragma unroll
            for (int q = 0; q < 2; ++q) { const int r = r0 + q * NGW;
                const float rstd2 = rsqrtf(wave_sum(rs2[q]) * (1.0f / DM) + EPS);
                bf16_t* hr = H + (size_t)r * LDH;
#pragma unroll
                for (int h = 0; h < 2; ++h) { f32x4 v0, v1;
#pragma unroll
                    for (int j = 0; j < 4; ++j) { v0[j] = xv[q][8 * h + j] * rstd2 * gn[2 * h][j]; v1[j] = xv[q][8 * h + 4 + j] * rstd2 * gn[2 * h + 1][j]; }
                    store8(hr + 512 * h + 8 * lane, v0, v1); } }
        }
    }
}

__device__ __forceinline__ bf16x8 tr_frag(const LAS unsigned char* p0, const LAS unsigned char* p1) {
    const s16x4 a = __builtin_amdgcn_ds_read_tr16_b64_v4i16((LAS s16x4*)p0);
    const s16x4 b = __builtin_amdgcn_ds_read_tr16_b64_v4i16((LAS s16x4*)p1);
    return __builtin_shufflevector(a, b, 0, 1, 2, 3, 4, 5, 6, 7);
}
__device__ __forceinline__ void phase_r1(LAS unsigned char* lds, const bf16_t* Kb, const bf16_t* Vb, bf16_t* ST, int G, int bid) {
    const int tid = threadIdx.x, w = __builtin_amdgcn_readfirstlane(tid >> 6), lane = tid & 63, li = lane & 15, g4 = lane >> 4, q4 = (lane & 15) >> 2, p4 = lane & 3;
    constexpr int KSTR = 544, VSTR = 96;
    LAS unsigned char* LK = lds; LAS unsigned char* LV = lds + 128 * KSTR;
    for (int unit = bid; unit < 256; unit += G) {
        const int xcd_ = unit & 7, j_ = unit >> 3, bh = xcd_ * 2 + (j_ >> 4), es = j_ & 15, b = bh >> 2, h = bh & 3;
        const float lg2 = log2f(1.0f - exp2f(-5.0f - (float)h));
        const float cd = exp2f(128.0f * lg2);
        const bf16_t* kbase = Kb + (size_t)(b * SEQ) * 1024 + h * 256;
        const bf16_t* vbase = Vb + (size_t)(b * SEQ) * 2048 + h * 512 + es * 32;
        const int vrow = tid >> 2, vc = tid & 3;
        const float kd = exp2f((float)(127 - vrow) * lg2);
        f32x4 S[2][2];
#pragma unroll
        for (int i = 0; i < 2; ++i)
#pragma unroll
            for (int j = 0; j < 2; ++j) S[i][j] = (f32x4){0.f, 0.f, 0.f, 0.f};
        u32x4 kr[2][8], vr[2];
#define R1_LOAD(buf, n_) do { const size_t ro_ = (size_t)(n_) * 128; \
        _Pragma("unroll") for (int i = 0; i < 8; ++i) { const int piece = tid + 512 * i; kr[buf][i] = *(const u32x4*)(kbase + (ro_ + (piece >> 5)) * 1024 + (piece & 31) * 8); } \
        vr[buf] = *(const u32x4*)(vbase + (ro_ + vrow) * 2048 + vc * 8); } while (0)
#define R1_STORE(np_) do { bf16_t* st = ST + ((size_t)(bh * 32 + (np_)) * 512) * 256; \
        _Pragma("unroll") for (int dt = 0; dt < 2; ++dt) _Pragma("unroll") for (int et = 0; et < 2; ++et) { const int e = 32 * es + 16 * et + li, d = 32 * w + 16 * dt + 4 * g4; \
            u32x2 o; o.x = cvt_pk_bf16(S[dt][et][0], S[dt][et][1]); o.y = cvt_pk_bf16(S[dt][et][2], S[dt][et][3]); *(u32x2*)(st + (size_t)e * 256 + d) = o; } } while (0)
#define R1_STEP(buf, n_) do { \
        __syncthreads(); \
        _Pragma("unroll") for (int i = 0; i < 8; ++i) { const int piece = tid + 512 * i; *(LAS u32x4*)(LK + (piece >> 5) * KSTR + (piece & 31) * 16) = kr[buf][i]; } \
        { const u32x4 v_ = vr[buf]; u32x4 o; o.x = cvt_pk_bf16(bf_lo(v_.x) * kd, bf_hi(v_.x) * kd); o.y = cvt_pk_bf16(bf_lo(v_.y) * kd, bf_hi(v_.y) * kd); \
          o.z = cvt_pk_bf16(bf_lo(v_.z) * kd, bf_hi(v_.z) * kd); o.w = cvt_pk_bf16(bf_lo(v_.w) * kd, bf_hi(v_.w) * kd); *(LAS u32x4*)(LV + vrow * VSTR + vc * 16) = o; } \
        __syncthreads(); \
        if ((n_) + 2 < 62) R1_LOAD(buf, (n_) + 2); \
        if (((n_) & 1) == 0) R1_STORE((n_) >> 1); \
        _Pragma("unroll") for (int i = 0; i < 2; ++i) _Pragma("unroll") for (int j = 0; j < 2; ++j) S[i][j] *= cd; \
        _Pragma("unroll") for (int ks = 0; ks < 4; ++ks) { const int row0_ = 32 * ks + 8 * g4 + q4; bf16x8 af[2], bfr[2]; \
            _Pragma("unroll") for (int dt = 0; dt < 2; ++dt) { const LAS unsigned char* p = LK + row0_ * KSTR + (32 * w + 16 * dt + 4 * p4) * 2; af[dt] = tr_frag(p, p + 4 * KSTR); } \
            _Pragma("unroll") for (int et = 0; et < 2; ++et) { const LAS unsigned char* p = LV + row0_ * VSTR + (16 * et + 4 * p4) * 2; bfr[et] = tr_frag(p, p + 4 * VSTR); } \
            _Pragma("unroll") for (int dt = 0; dt < 2; ++dt) _Pragma("unroll") for (int et = 0; et < 2; ++et) S[dt][et] = __builtin_amdgcn_mfma_f32_16x16x32_bf16(af[dt], bfr[et], S[dt][et], 0, 0, 0); } \
    } while (0)
        R1_LOAD(0, 0); R1_LOAD(1, 1);
        for (int n = 0; n < 62; n += 2) { R1_STEP(0, n); R1_STEP(1, n + 1); }
        R1_STORE(31);
        __syncthreads();
#undef R1_LOAD
#undef R1_STORE
#undef R1_STEP
    }
}

struct R2Unit { int r, bh, np, b, h, row0, nst; float lg2; };
__device__ __forceinline__ bool r2_decode(int i, int G, int bid, R2Unit& u) {
    const int unit = bid + G * i; if (unit >= 2048) return false;
    const int w_ = unit % G, i_ = unit / G, xcd_ = w_ & 7, j_ = w_ >> 3;
    int rest = (i_ * 64 + xcd_ * 8 + (j_ >> 2)) & 511; u.r = (j_ + i_) & 3;
    if (G != 256) { u.r = (unit >> 8) & 3; rest = (unit & 255) | ((unit >> 10) << 8); }
    u.bh = rest >> 5; u.np = rest & 31; u.b = u.bh >> 2; u.h = u.bh & 3;
    u.row0 = u.b * SEQ + u.np * 256 + u.r * 64; u.nst = (u.np > 0 ? 4 : 0) + u.r + 1; u.lg2 = log2f(1.0f - exp2f(-5.0f - (float)u.h)); return true;
}
__device__ __forceinline__ void phase_r2(LAS unsigned char* lds, const bf16_t* Qb, const bf16_t* Kb, const bf16_t* Vb, bf16_t* Gb, const bf16_t* ST, int G, int bid, bf16_t* Gout, int rowmask) {
    const int tid = threadIdx.x, w = __builtin_amdgcn_readfirstlane(tid >> 6), lane = tid & 63, li = lane & 15, g4 = lane >> 4, q4 = (lane & 15) >> 2, p4 = lane & 3;
    constexpr int QSTR = 528, VSTR = 1056, PSTR = 144, SSTR = 144;
    LAS unsigned char* LQ = lds; LAS unsigned char* LK = lds + 33792; LAS unsigned char* LV = LK + 33792; LAS unsigned char* LP = LV + 67584; LAS unsigned char* LS = LK;
    R2Unit cu, nu; int ui = 0, cs = 0;
    if (!r2_decode(0, G, bid, cu)) return;
    u32x4 pf[12];
    f32x4 acc[4][4];
    const unsigned voV = (unsigned)((tid >> 6) * 4096 + (tid & 63) * 16), voK = (unsigned)((tid >> 5) * 2048 + (tid & 31) * 16), voS = (unsigned)((tid >> 3) * 512 + (tid & 7) * 16);
#define R2_PREFETCH(u_, s_) do { const int nstS_ = (u_).np > 0 ? 4 : 0; \
        if ((s_) < nstS_) { const char* stb = (const char*)(ST + ((size_t)((u_).bh * 32 + (u_).np) * 512) * 256 + (s_) * 64); \
            _Pragma("unroll") for (int i = 0; i < 8; ++i) pf[i] = *(const u32x4*)(stb + (size_t)i * 32768 + voS); } \
        else { const int key0 = (u_).b * SEQ + (u_).np * 256 + ((s_) - nstS_) * 64; \
            const char* vb_ = (const char*)(Vb + (size_t)key0 * 2048 + (u_).h * 512); const char* kb_ = (const char*)(Kb + (size_t)key0 * 1024 + (u_).h * 256); \
            _Pragma("unroll") for (int i = 0; i < 8; ++i) pf[i] = *(const u32x4*)(vb_ + (size_t)i * 32768 + voV); \
            _Pragma("unroll") for (int i = 0; i < 4; ++i) pf[8 + i] = *(const u32x4*)(kb_ + (size_t)i * 32768 + voK); } \
        if ((s_) == 0 && nstS_ > 0) { const char* qb_ = (const char*)(Qb + (size_t)(u_).row0 * 1024 + (u_).h * 256); \
            _Pragma("unroll") for (int i = 0; i < 4; ++i) pf[8 + i] = *(const u32x4*)(qb_ + (size_t)i * 32768 + voK); } \
    } while (0)
    R2_PREFETCH(cu, 0);
    for (;;) {
        const int nstS = cu.np > 0 ? 4 : 0; const bool isS = cs < nstS;
        __syncthreads();
        if (isS) {
#pragma unroll
            for (int i = 0; i < 8; ++i) *(LAS u32x4*)(LS + ((tid >> 3) * SSTR + (tid & 7) * 16) + i * 64 * SSTR) = pf[i];
        } else {
#pragma unroll
            for (int i = 0; i < 8; ++i) *(LAS u32x4*)(LV + ((tid >> 6) * VSTR + (tid & 63) * 16) + i * 8 * VSTR) = pf[i];
#pragma unroll
            for (int i = 0; i < 4; ++i) *(LAS u32x4*)(LK + ((tid >> 5) * QSTR + (tid & 31) * 16) + i * 16 * QSTR) = pf[8 + i];
        }
        if (cs == 0) {
#pragma unroll
            for (int i = 0; i < 4; ++i) { u32x4 qv = pf[8 + i];
                if (nstS == 0) qv = *(const u32x4*)((const char*)(Qb + (size_t)cu.row0 * 1024 + cu.h * 256) + (size_t)i * 32768 + voK);
                *(LAS u32x4*)(LQ + ((tid >> 5) * QSTR + (tid & 31) * 16) + i * 16 * QSTR) = qv; }
#pragma unroll
            for (int i = 0; i < 4; ++i)
#pragma unroll
                for (int j = 0; j < 4; ++j) acc[i][j] = (f32x4){0.f, 0.f, 0.f, 0.f};
        }
        __syncthreads();
        bool have_next = true; int ns = cs + 1; const bool last_stage = (ns == cu.nst);
        if (last_stage) { have_next = r2_decode(ui + 1, G, bid, nu); ns = 0; } else nu = cu;
        if (have_next) R2_PREFETCH(nu, ns);
        if (isS) {
#pragma unroll 1
            for (int ks = 0; ks < 2; ++ks) {
                bf16x8 qf[4], sf[4];
#pragma unroll
                for (int it = 0; it < 4; ++it) qf[it] = *(const LAS bf16x8*)(LQ + (16 * it + li) * QSTR + (cs * 64 + ks * 32 + 8 * g4) * 2);
#pragma unroll
                for (int et = 0; et < 4; ++et) sf[et] = *(const LAS bf16x8*)(LS + (64 * w + 16 * et + li) * SSTR + (ks * 32 + 8 * g4) * 2);
#pragma unroll
                for (int et = 0; et < 4; ++et)
#pragma unroll
                    for (int it = 0; it < 4; ++it) acc[et][it] = __builtin_amdgcn_mfma_f32_16x16x32_bf16(sf[et], qf[it], acc[et][it], 0, 0, 0);
            }
            if (cs == 3) {
#pragma unroll
                for (int it = 0; it < 4; ++it) { const float s = exp2f((float)(64 * cu.r + 16 * it + li + 1) * cu.lg2);
#pragma unroll
                    for (int et = 0; et < 4; ++et) acc[et][it] *= s; }
            }
        } else {
            const int jb = cs - nstS;
            {
                const int it = w >> 1, jt0 = (w & 1) * 2;
                f32x4 pa[2] = {(f32x4){0.f, 0.f, 0.f, 0.f}, (f32x4){0.f, 0.f, 0.f, 0.f}};
#pragma unroll 2
                for (int ks = 0; ks < 8; ++ks) {
                    const bf16x8 qf = *(const LAS bf16x8*)(LQ + (16 * it + li) * QSTR + (ks * 32 + 8 * g4) * 2);
#pragma unroll
                    for (int jj = 0; jj < 2; ++jj) { const bf16x8 kf = *(const LAS bf16x8*)(LK + (16 * (jt0 + jj) + li) * QSTR + (ks * 32 + 8 * g4) * 2);
                        pa[jj] = __builtin_amdgcn_mfma_f32_16x16x32_bf16(kf, qf, pa[jj], 0, 0, 0); }
                }
                const int iq = 64 * cu.r + 16 * it + li;
#pragma unroll
                for (int jj = 0; jj < 2; ++jj) { const int jk0 = 64 * jb + 16 * (jt0 + jj) + 4 * g4; float pv[4];
#pragma unroll
                    for (int e = 0; e < 4; ++e) { const int dist = iq - (jk0 + e); pv[e] = dist >= 0 ? pa[jj][e] * exp2f((float)dist * cu.lg2) : 0.0f; }
                    u32x2 o; o.x = cvt_pk_bf16(pv[0], pv[1]); o.y = cvt_pk_bf16(pv[2], pv[3]);
                    *(LAS u32x2*)(LP + (16 * it + li) * PSTR + (16 * (jt0 + jj) + 4 * g4) * 2) = o; }
            }
            __syncthreads();
#pragma unroll 1
            for (int ks = 0; ks < 2; ++ks) {
                bf16x8 pfr[4], vf[4];
#pragma unroll
                for (int it = 0; it < 4; ++it) pfr[it] = *(const LAS bf16x8*)(LP + (16 * it + li) * PSTR + (ks * 32 + 8 * g4) * 2);
                const int vrow = 32 * ks + 8 * g4 + q4;
#pragma unroll
                for (int et = 0; et < 4; ++et) { const LAS unsigned char* p = LV + vrow * VSTR + (64 * w + 16 * et + 4 * p4) * 2; vf[et] = tr_frag(p, p + 4 * VSTR); }
#pragma unroll
                for (int et = 0; et < 4; ++et)
#pragma unroll
                    for (int it = 0; it < 4; ++it) acc[et][it] = __builtin_amdgcn_mfma_f32_16x16x32_bf16(vf[et], pfr[it], acc[et][it], 0, 0, 0);
            }
        }
        if (last_stage) {
            float s1[4], s2[4];
#pragma unroll
            for (int it = 0; it < 4; ++it) { float a1 = 0.f, a2 = 0.f;
#pragma unroll
                for (int et = 0; et < 4; ++et)
#pragma unroll
                    for (int e = 0; e < 4; ++e) { const float v = acc[et][it][e]; a1 += v; a2 += v * v; }
                a1 += __shfl_xor(a1, 16); a1 += __shfl_xor(a1, 32); a2 += __shfl_xor(a2, 16); a2 += __shfl_xor(a2, 32);
                s1[it] = a1; s2[it] = a2; }
            __syncthreads();
            LAS f32x2* red = (LAS f32x2*)LP;
            if (g4 == 0) {
#pragma unroll
                for (int it = 0; it < 4; ++it) red[(16 * it + li) * 8 + w] = (f32x2){s1[it], s2[it]};
            }
            __syncthreads();
#pragma unroll
            for (int it = 0; it < 4; ++it) { float a1 = 0.f, a2 = 0.f;
#pragma unroll
                for (int k = 0; k < 8; ++k) { const f32x2 t = red[(16 * it + li) * 8 + k]; a1 += t[0]; a2 += t[1]; }
                const float mu = a1 * (1.0f / 512.0f); const float var = fmaxf(a2 * (1.0f / 512.0f) - mu * mu, 0.0f); const float rstd = rsqrtf(var + EPS);
                bf16_t* grow = Gb + (size_t)(cu.row0 + 16 * it + li) * 2048 + cu.h * 512 + 64 * w + 4 * g4;
#pragma unroll
                for (int et = 0; et < 4; ++et) { const u32x2 gw2 = *(const u32x2*)(grow + 16 * et);
                    const float g0 = bf_lo(gw2.x), g1 = bf_hi(gw2.x), g2 = bf_lo(gw2.y), g3 = bf_hi(gw2.y);
                    const float o0 = (acc[et][it][0] - mu) * rstd * g0 * sigmoidf_(g0), o1 = (acc[et][it][1] - mu) * rstd * g1 * sigmoidf_(g1);
                    const float o2 = (acc[et][it][2] - mu) * rstd * g2 * sigmoidf_(g2), o3 = (acc[et][it][3] - mu) * rstd * g3 * sigmoidf_(g3);
                    u32x2 o; o.x = cvt_pk_bf16(o0, o1); o.y = cvt_pk_bf16(o2, o3);
                    *(u32x2*)(Gout + (size_t)((cu.row0 + 16 * it + li) & rowmask) * 2048 + cu.h * 512 + 64 * w + 4 * g4 + 16 * et) = o; }
                asm volatile("" ::: "memory");
            }
            if (!have_next) break;
            ++ui;
        }
        cu = nu; cs = ns;
    }
#undef R2_PREFETCH
    __syncthreads();
}

__device__ __forceinline__ void unpack8(const u32x4 w, float* f) { f[0] = bf_lo(w.x); f[1] = bf_hi(w.x); f[2] = bf_lo(w.y); f[3] = bf_hi(w.y); f[4] = bf_lo(w.z); f[5] = bf_hi(w.z); f[6] = bf_lo(w.w); f[7] = bf_hi(w.w); }
__device__ __forceinline__ void phase_conv(const bf16_t* U, const float* cw, const float* cb, bf16_t* UC, int G, int bid) {
    for (int unit = bid; unit < 768; unit += G) {
        const int idx = unit * 512 + threadIdx.x, cg8 = idx % 192, tb = idx / 192, c0 = cg8 * 8, row0 = tb * 16;
        const bool first = (row0 & (SEQ - 1)) == 0;
        u32x4 ur[19];
#pragma unroll
        for (int k = 0; k < 19; ++k) { if (k < 3 && first) ur[k] = (u32x4){0u, 0u, 0u, 0u}; else ur[k] = *(const u32x4*)(U + (size_t)(row0 - 3 + k) * LW + c0); }
        float w[4][8], bias[8];
#pragma unroll
        for (int j = 0; j < 4; ++j) { const f32x4 w0 = *(const f32x4*)(cw + j * LW + c0), w1 = *(const f32x4*)(cw + j * LW + c0 + 4);
#pragma unroll
            for (int k = 0; k < 4; ++k) { w[j][k] = w0[k]; w[j][4 + k] = w1[k]; } }
        { const f32x4 b0 = *(const f32x4*)(cb + c0), b1 = *(const f32x4*)(cb + c0 + 4);
#pragma unroll
          for (int k = 0; k < 4; ++k) { bias[k] = b0[k]; bias[4 + k] = b1[k]; } }
#pragma unroll
        for (int t = 0; t < 16; ++t) { float av[8];
#pragma unroll
            for (int k = 0; k < 8; ++k) av[k] = bias[k];
#pragma unroll
            for (int j = 0; j < 4; ++j) { float f[8]; unpack8(ur[t + j], f);
#pragma unroll
                for (int k = 0; k < 8; ++k) av[k] += w[j][k] * f[k]; }
            u32x4 o; o.x = cvt_pk_bf16(av[0], av[1]); o.y = cvt_pk_bf16(av[2], av[3]); o.z = cvt_pk_bf16(av[4], av[5]); o.w = cvt_pk_bf16(av[6], av[7]);
            *(u32x4*)(UC + (size_t)(row0 + t) * LW + c0) = o; }
    }
}
__device__ __forceinline__ void phase_scan1(const bf16_t* LA, const bf16_t* Bv, f32x2* Hc, f32x2* Lc, int G, int bid) {
    for (int unit = bid; unit < 768; unit += G) {
        const int idx = unit * 512 + threadIdx.x, cp = idx % 768, bc = idx / 768;
        const size_t base = (size_t)bc * 64 * LW + 2 * cp;
        float h0 = 0.f, h1 = 0.f, L0 = 0.f, L1 = 0.f;
        for (int t0 = 0; t0 < 64; t0 += 16) { unsigned la[16], bb[16];
#pragma unroll
            for (int k = 0; k < 16; ++k) { la[k] = *(const unsigned*)(LA + base + (size_t)(t0 + k) * LW); bb[k] = *(const unsigned*)(Bv + base + (size_t)(t0 + k) * LW); }
#pragma unroll
            for (int k = 0; k < 16; ++k) { const float l0 = bf_lo(la[k]), l1 = bf_hi(la[k]); h0 = __expf(l0) * h0 + bf_lo(bb[k]); h1 = __expf(l1) * h1 + bf_hi(bb[k]); L0 += l0; L1 += l1; } }
        Hc[idx] = (f32x2){h0, h1}; Lc[idx] = (f32x2){L0, L1};
    }
}
__device__ __forceinline__ void phase_scan2(const bf16_t* LA, const bf16_t* Bv, const f32x2* Hc, const f32x2* Lc, bf16_t* Y, int G, int bid) {
    for (int unit = bid; unit < 768; unit += G) {
        const int idx = unit * 512 + threadIdx.x, cp = idx % 768, bc = idx / 768, c = bc & 127, b = bc >> 7;
        float h0 = 0.f, h1 = 0.f;
        const f32x2* hp = Hc + (size_t)(b * 128) * 768 + cp; const f32x2* lp = Lc + (size_t)(b * 128) * 768 + cp;
        int cc = 0;
        for (; cc + 8 <= c; cc += 8) { f32x2 hh[8], ll[8];
#pragma unroll
            for (int k = 0; k < 8; ++k) { hh[k] = hp[(size_t)(cc + k) * 768]; ll[k] = lp[(size_t)(cc + k) * 768]; }
#pragma unroll
            for (int k = 0; k < 8; ++k) { h0 = __expf(ll[k][0]) * h0 + hh[k][0]; h1 = __expf(ll[k][1]) * h1 + hh[k][1]; } }
        for (; cc < c; ++cc) { const f32x2 hh = hp[(size_t)cc * 768], ll = lp[(size_t)cc * 768]; h0 = __expf(ll[0]) * h0 + hh[0]; h1 = __expf(ll[1]) * h1 + hh[1]; }
        const size_t base = (size_t)bc * 64 * LW + 2 * cp;
        for (int t0 = 0; t0 < 64; t0 += 16) { unsigned la[16], bb[16], yy[16];
#pragma unroll
            for (int k = 0; k < 16; ++k) { const size_t o = base + (size_t)(t0 + k) * LW; la[k] = *(const unsigned*)(LA + o); bb[k] = *(const unsigned*)(Bv + o); yy[k] = *(const unsigned*)(Y + o); }
#pragma unroll
            for (int k = 0; k < 16; ++k) { h0 = __expf(bf_lo(la[k])) * h0 + bf_lo(bb[k]); h1 = __expf(bf_hi(la[k])) * h1 + bf_hi(bb[k]);
                const float y0 = bf_lo(yy[k]), y1 = bf_hi(yy[k]);
                const float z0 = 1.5957691216057308f * (y0 + 0.044715f * y0 * y0 * y0), z1 = 1.5957691216057308f * (y1 + 0.044715f * y1 * y1 * y1);
                *(unsigned*)(Y + base + (size_t)(t0 + k) * LW) = cvt_pk_bf16(h0 * y0 * sigmoidf_(z0), h1 * y1 * sigmoidf_(z1)); } }
    }
}

#define XB_TMO      128
#define XB_XCNT(j)  (256  + 64 * (j))
#define XB_XSUB(j)  (1280 + 64 * (j))
#define XB_XGEN(j)  (2304 + 64 * (j))
#define XB_TOP      3328
#define XB_TOPGEN   3392
#define XCD_BAR_WORDS 3456
#define XB_SPIN_CAP (1u << 20)
__device__ __forceinline__ unsigned xb_ld(unsigned* p)              { return __hip_atomic_load(p, __ATOMIC_RELAXED, __HIP_MEMORY_SCOPE_AGENT); }
__device__ __forceinline__ unsigned xb_add(unsigned* p, unsigned v) { return __hip_atomic_fetch_add(p, v, __ATOMIC_RELAXED, __HIP_MEMORY_SCOPE_AGENT); }
__device__ __forceinline__ unsigned xb_xcc_id() { return (unsigned)__builtin_amdgcn_s_getreg((3 << 11) | 20) & 0xFu; }
#define XB_SPIN(cond, bar) do { unsigned _sp = 0; while (cond) { __builtin_amdgcn_s_sleep(1); \
    if ((++_sp & 255u) == 0u) { if (xb_ld(&(bar)[XB_TMO])) break; if (_sp > XB_SPIN_CAP) { atomicAdd(&(bar)[XB_TMO], 1u); break; } } } } while (0)
struct XcdBarrier { unsigned* bar; unsigned x; volatile LAS unsigned* st; };
__device__ __forceinline__ XcdBarrier xcd_barrier_post(unsigned* bar, volatile LAS unsigned* st) {
    XcdBarrier b; b.bar = bar; b.x = xb_xcc_id(); b.st = st;
    if (threadIdx.x == 0) (void)xb_add(&bar[XB_XCNT(b.x)], 1u);
    return b;
}
__device__ __forceinline__ void xcd_barrier_complete(unsigned* bar, unsigned x, unsigned& nloc, unsigned& nx) {
    const unsigned G = gridDim.x * gridDim.y * gridDim.z;
    unsigned sum, cnt, mine, sp = 0u;
    for (;;) {
        sum = 0u; cnt = 0u; mine = 0u;
#pragma unroll
        for (unsigned j = 0; j < 16; ++j) { const unsigned c = xb_ld(&bar[XB_XCNT(j)]); sum += c; cnt += (c > 0u) ? 1u : 0u; mine = (j == x) ? c : mine; }
        if (sum == G) break;
        __builtin_amdgcn_s_sleep(1);
        if ((++sp & 255u) == 0u) { if (xb_ld(&bar[XB_TMO])) break; if (sp > XB_SPIN_CAP) { atomicAdd(&bar[XB_TMO], 1u); break; } }
    }
    nloc = mine > 0u ? mine : 1u; nx = cnt > 0u ? cnt : 1u;
}
__device__ __forceinline__ void xcd_barrier(const XcdBarrier& b) {
    asm volatile("s_waitcnt vmcnt(0)" ::: "memory");
    __syncthreads();
    if (threadIdx.x == 0) {
        unsigned* bar = b.bar;
        __builtin_amdgcn_s_waitcnt(0);
        unsigned nloc = b.st[0], nx = b.st[1];
        if (nloc == 0u) { xcd_barrier_complete(bar, b.x, nloc, nx); b.st[0] = nloc; b.st[1] = nx; }
        const unsigned old = xb_add(&bar[XB_XSUB(b.x)], 1u);
        const unsigned gen = old / nloc;
        if (old + 1u == (gen + 1u) * nloc) {
            __builtin_amdgcn_fence(__ATOMIC_RELEASE, "agent");
            asm volatile("s_waitcnt vmcnt(0)" ::: "memory");
            const unsigned og = xb_add(&bar[XB_TOP], 1u);
            const unsigned tg = og / nx;
            if (og + 1u == (tg + 1u) * nx) xb_add(&bar[XB_TOPGEN], 1u);
            else XB_SPIN(xb_ld(&bar[XB_TOPGEN]) == tg, bar);
            __builtin_amdgcn_fence(__ATOMIC_ACQUIRE, "agent");
            xb_add(&bar[XB_XGEN(b.x)], 1u);
            asm volatile("s_waitcnt vmcnt(0)" ::: "memory");
        } else {
            XB_SPIN(xb_ld(&bar[XB_XGEN(b.x)]) == gen, bar);
            __builtin_amdgcn_fence(__ATOMIC_ACQUIRE, "agent");
            asm volatile("s_waitcnt vmcnt(0)" ::: "memory");
        }
    }
    __syncthreads();
}

__global__ void __launch_bounds__(512) fwd_megakernel(Args a) {
    extern __shared__ __attribute__((aligned(16))) unsigned char lds_raw[];
    LAS unsigned char* lds = (LAS unsigned char*)lds_raw;
    cg::grid_group grid = cg::this_grid();
    const int tid = threadIdx.x, lane = tid & 63, wave = __builtin_amdgcn_readfirstlane(tid >> 6);
    const int G = gridDim.x, bid = blockIdx.x;
    const int gw = bid * 8 + wave, NGW = G * 8;
    unsigned char* ws = a.ws;
    const float* x = a.in[0]; const float* conv_w = a.in[4]; const float* conv_b = a.in[5]; const float* gate_b = a.in[7]; const float* a_param = a.in[8];
    const float* ng = a.in[10];
    bf16_t* H = (bf16_t*)(ws + WS_H);
    bf16_t* Qb = (bf16_t*)(ws + WS_Q); bf16_t* Kb = (bf16_t*)(ws + WS_K); bf16_t* Vb = (bf16_t*)(ws + WS_V); bf16_t* Gb = (bf16_t*)(ws + WS_G);
    bf16_t* ST = (bf16_t*)a.out;
    bf16_t* Y = (bf16_t*)(ws + WS_Y); bf16_t* U = (bf16_t*)(ws + WS_U); bf16_t* UC = (bf16_t*)(ws + WS_UC); bf16_t* Bv = (bf16_t*)(ws + WS_B); bf16_t* LA = U;
    f32x2* Hc = (f32x2*)(ws + WS_H); f32x2* Lc = Hc + 4 * 128 * 768;
    const int lo = a.ph_lo, hi = a.ph_hi;
    volatile LAS unsigned* bst = (volatile LAS unsigned*)(lds + LDS_BYTES - 64);
    if (tid == 0) { bst[0] = 0u; bst[1] = 0u; }
    __syncthreads();
    XcdBarrier xbar; xbar.bar = (unsigned*)(ws + WS_SCAN); xbar.x = 0; xbar.st = bst;
    if (a.coop) xbar = xcd_barrier_post((unsigned*)(ws + WS_SCAN), bst);
#ifndef PHMASK
#define PHMASK 0x7ffff
#endif
#define IN(k) (((PHMASK >> (k)) & 1) && lo <= (k) && (k) < hi)
#define SEAM(k) do { if (a.coop && IN((k) + 1)) { if ((k) == 0) grid.sync(); else xcd_barrier(xbar); } } while (0)
#ifndef REPMASK
#define REPMASK 0
#endif
#ifndef STAGGER_TICKS
#define STAGGER_TICKS 0u
#endif
#define REP(k, stmt) do { stmt; if ((REPMASK >> (k)) & 1) { stmt; } } while (0)
    pg8::StaticOrder S;
    if (IN(0)) { REP(0, phase_prologue(a, lds, gw, NGW, wave, lane_id_fresh())); SEAM(0); }
    if (IN(1)) { pg8::Gemm g{H, (const bf16_t*)(ws + WS_WRIN), MTOK, 6144, 1024, LDH, LDW, 1 << 20, 0}; S.init(MTOK, 6144, G, bid);
        EpiRetIn E{Qb, Kb, Vb, Gb}; pg8::gemm_phase(lds, g, S, E, STAGGER_TICKS); if ((REPMASK >> 1) & 1) { EpiNull E0{H}; pg8::gemm_phase(lds, g, S, E0, STAGGER_TICKS); } SEAM(1); }
    if (IN(2)) { REP(2, phase_r1(lds, Kb, Vb, ST, G, bid)); SEAM(2); }
    if (IN(3)) { if ((REPMASK >> 3) & 1) phase_r2(lds, Qb, Kb, Vb, Gb, ST, G, bid, H, 16383); phase_r2(lds, Qb, Kb, Vb, Gb, ST, G, bid, Gb, 0x7fffffff); SEAM(3); }
    if (IN(4)) { pg8::Gemm g{Gb, (const bf16_t*)(ws + WS_WROUT), MTOK, 1024, 2048, 2048, 2048, 1 << 20, 0}; S.init(MTOK, 1024, G, bid);
        EpiPlain E{H, LDH}; REP(4, pg8::gemm_phase(lds, g, S, E)); SEAM(4); }
    if (IN(5)) { phase_norm_res(x, H, ng + 1 * DM, ng + 2 * DM, a.out, H, gw, NGW, lane_id_fresh()); SEAM(5); }
    if (IN(6)) { pg8::Gemm g{H, (const bf16_t*)(ws + WS_WFIN), MTOK, 5632, 1024, LDH, LDW, 1 << 20, 0}; S.init(MTOK, 5632, G, bid);
        EpiSwiglu E{(bf16_t*)(ws + WS_HID0)}; REP(6, pg8::gemm_phase(lds, g, S, E, STAGGER_TICKS)); SEAM(6); }
    if (IN(7)) { pg8::Gemm g{(const bf16_t*)(ws + WS_HID0), (const bf16_t*)(ws + WS_WFOUT), MTOK, 1024, DFF, DFF, DFF, 1 << 20, 0}; S.init(MTOK, 1024, G, bid);
        EpiPlain E{H, LDH}; REP(7, pg8::gemm_phase(lds, g, S, E)); SEAM(7); }
    if (IN(8)) { phase_norm_res(a.out, H, ng + 3 * DM, ng + 4 * DM, a.out, H, gw, NGW, lane_id_fresh()); SEAM(8); }
    if (IN(9)) { pg8::Gemm g{H, (const bf16_t*)(ws + WS_WLIN), MTOK, 3072, 1024, LDH, LDW, 1 << 20, 0}; S.init(MTOK, 3072, G, bid);
        EpiLruIn E{Y, U}; REP(9, pg8::gemm_phase(lds, g, S, E, STAGGER_TICKS)); SEAM(9); }
    if (IN(10)) { REP(10, phase_conv(U, conv_w, conv_b, UC, G, bid)); SEAM(10); }
    if (IN(11)) { pg8::Gemm g{UC, (const bf16_t*)(ws + WS_WG), MTOK, 3072, 256, LW, 256, 2, 512}; S.init(MTOK, 3072, G, bid);
        EpiGates E{UC, gate_b, a_param, LA, Bv}; REP(11, (pg8::gemm_phase<EpiGates, true, false>(lds, g, S, E))); SEAM(11); }
    if (IN(12)) { REP(12, phase_scan1(LA, Bv, Hc, Lc, G, bid)); SEAM(12); }
    if (IN(13)) { phase_scan2(LA, Bv, Hc, Lc, Y, G, bid); SEAM(13); }
    if (IN(14)) { pg8::Gemm g{Y, (const bf16_t*)(ws + WS_WLOUT), MTOK, 1024, LW, LW, LW, 1 << 20, 0}; S.init(MTOK, 1024, G, bid);
        EpiPlain E{H, LDH}; REP(14, pg8::gemm_phase(lds, g, S, E)); SEAM(14); }
    if (IN(15)) { phase_norm_res(a.out, H, ng + 5 * DM, ng + 6 * DM, a.out, H, gw, NGW, lane_id_fresh()); SEAM(15); }
    if (IN(16)) { pg8::Gemm g{H, (const bf16_t*)(ws + WS_WFIN) + (size_t)5632 * LDW, MTOK, 5632, 1024, LDH, LDW, 1 << 20, 0}; S.init(MTOK, 5632, G, bid);
        EpiSwiglu E{(bf16_t*)(ws + WS_HID1)}; REP(16, pg8::gemm_phase(lds, g, S, E, STAGGER_TICKS)); SEAM(16); }
    if (IN(17)) { pg8::Gemm g{(const bf16_t*)(ws + WS_HID1), (const bf16_t*)(ws + WS_WFOUT) + (size_t)1024 * DFF, MTOK, 1024, DFF, DFF, DFF, 1 << 20, 0}; S.init(MTOK, 1024, G, bid);
        EpiPlain E{H, LDH}; REP(17, pg8::gemm_phase(lds, g, S, E)); SEAM(17); }
    if (IN(18)) { if ((REPMASK >> 18) & 1) phase_norm_res(a.out, H, ng + 7 * DM, nullptr, (float*)(ws + WS_Q), H, gw, NGW, lane_id_fresh());
        phase_norm_res(a.out, H, ng + 7 * DM, nullptr, a.out, H, gw, NGW, lane_id_fresh()); }
    if (((REPMASK >> 19) & 1) && a.coop) { for (int i = 0; i < 18; ++i) grid.sync(); }
#undef IN
#undef SEAM
}

extern "C" void kernel_launch(void* const* d_in, const int* in_sizes, int n_in, void* d_out, int out_size, void* d_ws, size_t ws_size, hipStream_t stream) {
    static int grid = 0;
    if (grid == 0) {
        if (n_in != 13 || out_size != MTOK * DM || ws_size < WS_NEED) { fprintf(stderr, "kernel_launch: unexpected shapes (n_in %d out %d ws %zu)\n", n_in, out_size, ws_size); grid = -1; return; }
        int dev = 0, cus = 0, per_cu = 0;
        hipGetDevice(&dev); hipDeviceGetAttribute(&cus, hipDeviceAttributeMultiprocessorCount, dev);
        hipFuncSetAttribute((const void*)fwd_megakernel, hipFuncAttributeMaxDynamicSharedMemorySize, LDS_BYTES);
        hipOccupancyMaxActiveBlocksPerMultiprocessor(&per_cu, (const void*)fwd_megakernel, 512, LDS_BYTES);
        if (per_cu < 1) { fprintf(stderr, "kernel_launch: occupancy query says %d blocks per CU\n", per_cu); per_cu = 1; }
        (void)hipGetLastError();
        grid = cus * per_cu;
    }
    if (grid < 0) return;
    Args a{};
    for (int i = 0; i < 13; ++i) a.in[i] = (const float*)d_in[i];
    a.out = (float*)d_out; a.ws = (unsigned char*)d_ws;
#if MK_MULTI
    for (int ph = 0; ph < NPHASE; ++ph) { a.ph_lo = ph; a.ph_hi = ph + 1; a.coop = 0;
        hipLaunchKernelGGL(fwd_megakernel, dim3(grid), dim3(512), LDS_BYTES, stream, a); }
#else
    a.ph_lo = 0; a.ph_hi = NPHASE; a.coop = 1;
    if (hipMemsetAsync((char*)d_ws + WS_SCAN, 0, 16384, stream) != hipSuccess) { fprintf(stderr, "kernel_launch: memset of the barrier words failed\n"); return; }
    void* args[] = {&a};
    hipError_t e = hipLaunchCooperativeKernel((const void*)fwd_megakernel, dim3(grid), dim3(512), args, LDS_BYTES, stream);
    if (e != hipSuccess) fprintf(stderr, "cooperative launch failed: %s (grid %d)\n", hipGetErrorString(e), grid);
#endif
}
```

```cpp
#include <hip/hip_runtime.h>
#include <hip/hip_cooperative_groups.h>
#include <cstdio>
#include <cstdint>
namespace cg = cooperative_groups;

#ifndef MK_MULTI
#define MK_MULTI 0
#endif

#define LAS __attribute__((address_space(3)))
typedef unsigned short bf16_t;
typedef short bf16x8 __attribute__((ext_vector_type(8)));
typedef short s16x4 __attribute__((ext_vector_type(4)));
typedef float f32x4 __attribute__((ext_vector_type(4)));
typedef float f32x2 __attribute__((ext_vector_type(2)));
typedef unsigned u32x4 __attribute__((ext_vector_type(4)));
typedef unsigned u32x2 __attribute__((ext_vector_type(2)));

constexpr int MTOK = 32768, SEQ = 8192, DM = 1024;
constexpr int DFF = 2816, LW = 1536;
constexpr float EPS = 1e-6f;
constexpr size_t MiB = 1u << 20;
constexpr int LDH = 1088;
constexpr int LDW = 1024;
constexpr size_t WS_WRIN = 0, WS_WROUT = 12 * MiB, WS_WLIN = 16 * MiB, WS_WG = 22 * MiB, WS_WLOUT = 23 * MiB + MiB / 2,
                 WS_WFIN = 26 * MiB + MiB / 2, WS_WFOUT = 48 * MiB + MiB / 2;
constexpr size_t WS_SCAN = 59 * MiB + MiB / 2;
constexpr size_t WS_H = 60 * MiB;
static_assert(WS_H + (size_t)32768 * LDH * 2 <= 128 * MiB, "d_ws map");
constexpr size_t WS_Q = 128 * MiB, WS_K = 192 * MiB, WS_V = 256 * MiB, WS_G = 384 * MiB;
constexpr size_t WS_HID0 = 128 * MiB;
constexpr size_t WS_Y = 128 * MiB, WS_U = 224 * MiB, WS_UC = 320 * MiB, WS_B = 416 * MiB;
constexpr size_t WS_HID1 = 224 * MiB;
constexpr size_t WS_XB = 448 * MiB;
constexpr size_t WS_NEED = 512 * MiB;
constexpr int LDS_BYTES = 147456;
constexpr int NPHASE = 19;

__device__ __forceinline__ unsigned cvt_pk_bf16(float lo, float hi) { unsigned r; asm volatile("v_cvt_pk_bf16_f32 %0, %1, %2" : "=v"(r) : "v"(lo), "v"(hi)); return r; }
__device__ __forceinline__ float bf_lo(unsigned w) { return __uint_as_float(w << 16); }
__device__ __forceinline__ float bf_hi(unsigned w) { return __uint_as_float(w & 0xffff0000u); }
__device__ __forceinline__ void store8(bf16_t* p, f32x4 v0, f32x4 v1) {
    u32x4 w; w.x = cvt_pk_bf16(v0[0], v0[1]); w.y = cvt_pk_bf16(v0[2], v0[3]); w.z = cvt_pk_bf16(v1[0], v1[1]); w.w = cvt_pk_bf16(v1[2], v1[3]);
    *(u32x4*)p = w;
}
__device__ __forceinline__ float wave_sum(float v) {
#pragma unroll
    for (int o = 1; o < 64; o <<= 1) v += __shfl_xor(v, o);
    return v;
}
__device__ __forceinline__ int lane_id_fresh() { return (int)__builtin_amdgcn_mbcnt_hi(~0u, __builtin_amdgcn_mbcnt_lo(~0u, 0u)); }
__device__ __forceinline__ float sigmoidf_(float x) { return __builtin_amdgcn_rcpf(1.0f + __builtin_amdgcn_exp2f(-1.4426950408889634f * x)); }

namespace pg8 {
constexpr int BM = 256, BK = 64, HALF = 128, HTB = HALF * BK * 2, STAGE_BYTES = 8 * HTB, NXCD = 8, WGM = 8;
__host__ __device__ __forceinline__ int lds_byte(int r, int c) { const int st = (r >> 4) * 2 + (c >> 5), rr = r & 15, cc = c & 31, ob = rr * 64 + cc * 2; return st * 1024 + (ob ^ (((ob >> 9) & 1) << 5)); }
__host__ __device__ __forceinline__ void stage_rc(int b, int& R, int& C) { const int st = b / 1024, sb = b % 1024, swz = sb ^ (((sb >> 9) & 1) << 5); R = (st >> 1) * 16 + swz / 64; C = (st & 1) * 32 + (swz % 64) / 2; }
__host__ __device__ __forceinline__ int perm32(int rho) { const int n = rho >> 4, i = rho & 15; return 8 * (i >> 2) + 4 * n + (i & 3); }

struct Unit { int pm, pn; };
struct Gemm { const bf16_t* A; const bf16_t* Bt; int M, N, K, lda, ldb, npg; size_t goffA; };

struct StaticOrder {
    int nM, nN, nwg, G, c;
    __host__ __device__ void init(int M, int N, int G_, int c_) { nM = M / BM; nN = N / BM; nwg = nM * nN; G = G_; c = c_; }
    __host__ __device__ bool next(int i, Unit& u) const {
        const long L = (long)i * G + c; if (L >= nwg) return false;
        int wgid = (int)L; { const int q = nwg / NXCD, r = nwg % NXCD, xcd = wgid % NXCD, off = wgid / NXCD; wgid = (xcd < r ? xcd * (q + 1) : r * (q + 1) + (xcd - r) * q) + off; }
        const int nig = WGM * nN, gid = wgid / nig, fm = gid * WGM, gsz = (nM - fm) < WGM ? (nM - fm) : WGM;
        u.pm = fm + ((wgid % nig) % gsz); u.pn = (wgid % nig) / gsz; return true;
    }
};

template <class Epi, bool ALIGN_EPI = true, bool SP2 = true>
__device__ __forceinline__ void gemm_phase(LAS unsigned char* lds, const Gemm g, const StaticOrder& S, const Epi& E, unsigned stagger_ticks = 0) {
    if (stagger_ticks) {
        const unsigned long long t0 = __builtin_amdgcn_s_memrealtime(); const unsigned long long wait = (unsigned long long)(((unsigned)__builtin_amdgcn_s_getreg((3 << 11) | 20) & 7u) * stagger_ticks);
        while (__builtin_amdgcn_s_memrealtime() - t0 < wait) __builtin_amdgcn_s_sleep(8);
    }
    const int tid = threadIdx.x, wid = __builtin_amdgcn_readfirstlane(tid >> 6), lane = tid & 63, wr = wid >> 2, wc = wid & 3, fr = lane & 15, fq = lane >> 4;
    const int K = g.K, nt = K / BK;
    unsigned voffA[2], voffB[2];
#pragma unroll
    for (int i = 0; i < 2; ++i) { int R, C; stage_rc(tid * 16 + i * 8192, R, C); const int Rb = (R & ~31) + perm32(R & 31);
        voffA[i] = (unsigned)(R * g.lda + C) * 2u; voffB[i] = (unsigned)(Rb * g.ldb + C) * 2u; }
    const size_t kstep = (size_t)(BK * 2);
    const size_t hstepA = (size_t)HALF * g.lda * 2, hstepB = (size_t)HALF * g.ldb * 2;
    const size_t tstepA = 2 * hstepA, tstepB = 2 * hstepB;
    const unsigned ldsw = (unsigned)wid * 1024u;
    const int aoff = lds_byte(wr * 64 + fr, fq * 8), boff = lds_byte(wc * 32 + fr, fq * 8);
#define PG8_SA(b, h) (((b) * 2 + (h)) * HTB)
#define PG8_SB(b, h) ((4 + (b) * 2 + (h)) * HTB)
#define PG8_STAGE(bufoff, gbase, voff) do { _Pragma("unroll") for (int _i = 0; _i < 2; ++_i) \
        __builtin_amdgcn_global_load_lds((const unsigned*)((const char*)(gbase) + (voff)[_i]), (LAS unsigned*)(lds + (bufoff) + ldsw + _i * 8192), 16, 0, 0); } while (0)
#define PG8_LDA(dst, b, h) do { _Pragma("unroll") for (int m = 0; m < 4; ++m) _Pragma("unroll") for (int k = 0; k < 2; ++k) dst[m][k] = *(const LAS bf16x8*)(lds + PG8_SA(b, h) + aoff + m * 2048 + k * 1024); } while (0)
#define PG8_LDB(dst, b, h) do { _Pragma("unroll") for (int n = 0; n < 2; ++n) _Pragma("unroll") for (int k = 0; k < 2; ++k) dst[n][k] = *(const LAS bf16x8*)(lds + PG8_SB(b, h) + boff + n * 2048 + k * 1024); } while (0)
#define PG8_MMA(ai, bj, At, Bt) do { __builtin_amdgcn_s_setprio(1); _Pragma("unroll") for (int m = 0; m < 4; ++m) _Pragma("unroll") for (int n = 0; n < 2; ++n) _Pragma("unroll") for (int k = 0; k < 2; ++k) \
        acc[ai][bj][m][n] = __builtin_amdgcn_mfma_f32_16x16x32_bf16(Bt[n][k], At[m][k], acc[ai][bj][m][n], 0, 0, 0); __builtin_amdgcn_s_setprio(0); } while (0)
#define PG8_WAIT_V(n) asm volatile("s_waitcnt vmcnt(" #n ")" ::: "memory")
#define PG8_WAIT_L(n) asm volatile("s_waitcnt lgkmcnt(" #n ")" ::: "memory")
#define PG8_BAR __builtin_amdgcn_s_barrier()
#define PG8_SCHED __builtin_amdgcn_sched_barrier(0)
#define PG8_APTR(u) ((const char*)g.A + (size_t)(u).pm * tstepA + (size_t)((u).pn / g.npg) * g.goffA)
#define PG8_BPTR(u) ((const char*)g.Bt + (size_t)(u).pn * tstepB)
    Unit cur, nxt; int ui = 0;
    if (!S.next(0, cur)) return;
    f32x4 acc[2][2][4][2];
#pragma unroll
    for (int a = 0; a < 2; ++a)
#pragma unroll
        for (int b = 0; b < 2; ++b)
#pragma unroll
            for (int m = 0; m < 4; ++m)
#pragma unroll
                for (int n = 0; n < 2; ++n) acc[a][b][m][n] = (f32x4){0.f, 0.f, 0.f, 0.f};
    bf16x8 At[4][2], B0[2][2], B1[2][2];
    const char* cA = PG8_APTR(cur); const char* cB = PG8_BPTR(cur);
    if constexpr (SP2) {
        PG8_STAGE(PG8_SB(0, 0), cB, voffB); PG8_STAGE(PG8_SB(0, 1), cB + hstepB, voffB); PG8_STAGE(PG8_SA(0, 0), cA, voffA); PG8_STAGE(PG8_SA(0, 1), cA + hstepA, voffA);
        if (wr == 1) PG8_BAR;
        PG8_WAIT_V(2); PG8_BAR;
        PG8_STAGE(PG8_SB(1, 0), cB + kstep, voffB); PG8_STAGE(PG8_SA(1, 0), cA + kstep, voffA); PG8_STAGE(PG8_SB(1, 1), cB + hstepB + kstep, voffB);
        PG8_WAIT_V(6); PG8_BAR;
    } else {
        PG8_STAGE(PG8_SB(0, 0), cB, voffB); PG8_STAGE(PG8_SA(0, 0), cA, voffA); PG8_STAGE(PG8_SB(0, 1), cB + hstepB, voffB); PG8_STAGE(PG8_SA(0, 1), cA + hstepA, voffA);
        if (wr == 1) PG8_BAR;
        PG8_WAIT_V(4); PG8_BAR;
        PG8_STAGE(PG8_SB(1, 0), cB + kstep, voffB); PG8_STAGE(PG8_SA(1, 0), cA + kstep, voffA); PG8_STAGE(PG8_SB(1, 1), cB + hstepB + kstep, voffB);
        PG8_WAIT_V(6); PG8_BAR;
    }
    for (;;) {
        const bool has_next = S.next(ui + 1, nxt);
        const char* nA = has_next ? PG8_APTR(nxt) : cA; const char* nB = has_next ? PG8_BPTR(nxt) : cB;
        for (int t = 0; t < nt; t += 2) {
            const bool last = (t == nt - 2);
            const char* a1 = cA + (size_t)(t + 1) * kstep;
            const char* a2 = last ? nA : cA + (size_t)(t + 2) * kstep; const char* b2 = last ? nB : cB + (size_t)(t + 2) * kstep;
            const char* a3 = a2 + kstep; const char* b3 = b2 + kstep;
            if constexpr (SP2) {
            PG8_LDB(B0, 0, 0); PG8_LDB(B1, 0, 1); PG8_SCHED; PG8_LDA(At, 0, 0); PG8_STAGE(PG8_SA(1, 1), a1 + hstepA, voffA);
            PG8_WAIT_V(8); PG8_WAIT_L(0); PG8_BAR; PG8_MMA(0, 0, At, B0); PG8_MMA(0, 1, At, B1); PG8_BAR; PG8_SCHED;
            PG8_LDA(At, 0, 1); PG8_STAGE(PG8_SB(0, 0), b2, voffB); PG8_STAGE(PG8_SB(0, 1), b2 + hstepB, voffB); PG8_STAGE(PG8_SA(0, 0), a2, voffA);
            PG8_WAIT_V(8); PG8_WAIT_L(0); PG8_BAR; PG8_MMA(1, 0, At, B0); PG8_MMA(1, 1, At, B1); PG8_BAR; PG8_SCHED;
            PG8_LDB(B0, 1, 0); PG8_LDB(B1, 1, 1); PG8_SCHED; PG8_LDA(At, 1, 0); PG8_STAGE(PG8_SA(0, 1), a2 + hstepA, voffA);
            PG8_WAIT_V(8); PG8_WAIT_L(0); PG8_BAR; PG8_MMA(0, 0, At, B0); PG8_MMA(0, 1, At, B1); PG8_BAR; PG8_SCHED;
            PG8_LDA(At, 1, 1); PG8_STAGE(PG8_SB(1, 0), b3, voffB); PG8_STAGE(PG8_SB(1, 1), b3 + hstepB, voffB); PG8_STAGE(PG8_SA(1, 0), a3, voffA);
            PG8_WAIT_V(8); PG8_WAIT_L(0); PG8_BAR; PG8_MMA(1, 0, At, B0); PG8_MMA(1, 1, At, B1); PG8_BAR; PG8_SCHED;
            } else {
            PG8_LDB(B0, 0, 0); PG8_SCHED; PG8_LDA(At, 0, 0); PG8_STAGE(PG8_SA(1, 1), a1 + hstepA, voffA);
            PG8_WAIT_L(8); PG8_BAR; PG8_WAIT_L(0); PG8_MMA(0, 0, At, B0); PG8_BAR; PG8_SCHED;
            PG8_LDB(B1, 0, 1); PG8_STAGE(PG8_SB(0, 0), b2, voffB);
            PG8_BAR; PG8_WAIT_L(0); PG8_MMA(0, 1, At, B1); PG8_BAR;
            PG8_LDA(At, 0, 1); PG8_STAGE(PG8_SA(0, 0), a2, voffA);
            PG8_BAR; PG8_WAIT_L(0); PG8_MMA(1, 0, At, B0); PG8_BAR; PG8_SCHED;
            PG8_STAGE(PG8_SB(0, 1), b2 + hstepB, voffB);
            PG8_WAIT_V(6); PG8_BAR; PG8_MMA(1, 1, At, B1); PG8_BAR;
            PG8_LDB(B0, 1, 0); PG8_SCHED; PG8_LDA(At, 1, 0); PG8_STAGE(PG8_SA(0, 1), a2 + hstepA, voffA);
            PG8_WAIT_L(8); PG8_BAR; PG8_WAIT_L(0); PG8_MMA(0, 0, At, B0); PG8_BAR; PG8_SCHED;
            PG8_LDB(B1, 1, 1); PG8_STAGE(PG8_SB(1, 0), b3, voffB);
            PG8_BAR; PG8_WAIT_L(0); PG8_MMA(0, 1, At, B1); PG8_BAR;
            PG8_LDA(At, 1, 1); PG8_STAGE(PG8_SA(1, 0), a3, voffA);
            PG8_BAR; PG8_WAIT_L(0); PG8_MMA(1, 0, At, B0); PG8_BAR; PG8_SCHED;
            PG8_STAGE(PG8_SB(1, 1), b3 + hstepB, voffB);
            PG8_WAIT_V(6); PG8_BAR; PG8_MMA(1, 1, At, B1); PG8_BAR;
            }
        }
        if constexpr (ALIGN_EPI) { if (wr == 0) PG8_BAR; }
        E(acc, cur, wr, wc, fr, fq);
        if (!has_next) break;
#pragma unroll
        for (int a = 0; a < 2; ++a)
#pragma unroll
            for (int b = 0; b < 2; ++b)
#pragma unroll
                for (int m = 0; m < 4; ++m)
#pragma unroll
                    for (int n = 0; n < 2; ++n) acc[a][b][m][n] = (f32x4){0.f, 0.f, 0.f, 0.f};
        cur = nxt; cA = nA; cB = nB; ++ui;
        if constexpr (ALIGN_EPI) { if (wr == 1) PG8_BAR; }
    }
    PG8_WAIT_V(0);
    if constexpr (!ALIGN_EPI) { if (wr == 0) PG8_BAR; }
    PG8_BAR;
#undef PG8_SA
#undef PG8_SB
#undef PG8_STAGE
#undef PG8_LDA
#undef PG8_LDB
#undef PG8_MMA
#undef PG8_WAIT_V
#undef PG8_WAIT_L
#undef PG8_BAR
#undef PG8_SCHED
#undef PG8_APTR
#undef PG8_BPTR
}
}
typedef f32x4 Acc[2][2][4][2];

struct EpiPlain {
    bf16_t* O; int ldc;
    __device__ __forceinline__ void operator()(const Acc& acc, const pg8::Unit& u, int wr, int wc, int fr, int fq) const {
        const int row0 = u.pm * 256 + wr * 64 + fr, col0 = u.pn * 256 + wc * 32 + 8 * fq;
#pragma unroll
        for (int ai = 0; ai < 2; ++ai)
#pragma unroll
            for (int m = 0; m < 4; ++m) { bf16_t* rowp = O + (size_t)(row0 + ai * 128 + m * 16) * ldc + col0;
#pragma unroll
                for (int bj = 0; bj < 2; ++bj) store8(rowp + bj * 128, acc[ai][bj][m][0], acc[ai][bj][m][1]); }
    }
};
struct EpiRetIn {
    bf16_t *Q, *K, *V, *G;
    __device__ __forceinline__ void operator()(const Acc& acc, const pg8::Unit& u, int wr, int wc, int fr, int fq) const {
        const int row0 = u.pm * 256 + wr * 64 + fr, cl = wc * 32 + 8 * fq;
        if (u.pn < 8) {
            const int head = u.pn & 3; bf16_t* dst = (u.pn < 4 ? Q : K) + head * 256 + cl; const float sc = u.pn < 4 ? 1.0f : 0.0625f;
            float inv[2][4];
#pragma unroll
            for (int n = 0; n < 2; ++n)
#pragma unroll
                for (int j = 0; j < 4; ++j) inv[n][j] = __builtin_amdgcn_exp2f(-(float)(cl + 4 * n + j) * 0.10381025296523f);
#pragma unroll
            for (int ai = 0; ai < 2; ++ai)
#pragma unroll
                for (int m = 0; m < 4; ++m) { const int row = row0 + ai * 128 + m * 16; const float pos = (float)(row & (SEQ - 1));
                    f32x4 o1[2], o2[2];
#pragma unroll
                    for (int n = 0; n < 2; ++n)
#pragma unroll
                        for (int j = 0; j < 4; ++j) { float t = (pos * inv[n][j]) * 0.15915494309189535f; t = t - floorf(t);
                            const float s = __builtin_amdgcn_sinf(t), c = __builtin_amdgcn_cosf(t);
                            const float x1 = acc[ai][0][m][n][j], x2 = acc[ai][1][m][n][j];
                            o1[n][j] = (x1 * c - x2 * s) * sc; o2[n][j] = (x1 * s + x2 * c) * sc; }
                    bf16_t* rowp = dst + (size_t)row * 1024;
                    store8(rowp, o1[0], o1[1]); store8(rowp + 128, o2[0], o2[1]); }
        } else if (u.pn < 16) {
            bf16_t* dst = V + (u.pn - 8) * 256 + cl;
#pragma unroll
            for (int ai = 0; ai < 2; ++ai)
#pragma unroll
                for (int m = 0; m < 4; ++m) { bf16_t* rowp = dst + (size_t)(row0 + ai * 128 + m * 16) * 2048;
#pragma unroll
                    for (int bj = 0; bj < 2; ++bj) store8(rowp + bj * 128, acc[ai][bj][m][0], acc[ai][bj][m][1]); }
        } else {
            bf16_t* dst = G + (u.pn - 16) * 256 + cl;
#pragma unroll
            for (int ai = 0; ai < 2; ++ai)
#pragma unroll
                for (int m = 0; m < 4; ++m) { bf16_t* rowp = dst + (size_t)(row0 + ai * 128 + m * 16) * 2048;
#pragma unroll
                    for (int bj = 0; bj < 2; ++bj) store8(rowp + bj * 128, acc[ai][bj][m][0], acc[ai][bj][m][1]); }
        }
    }
};
struct EpiNull {
    bf16_t* O;
    __device__ __forceinline__ void operator()(const Acc& acc, const pg8::Unit& u, int wr, int wc, int fr, int fq) const {
        float s = 0.f;
#pragma unroll
        for (int ai = 0; ai < 2; ++ai)
#pragma unroll
            for (int bj = 0; bj < 2; ++bj)
#pragma unroll
                for (int m = 0; m < 4; ++m)
#pragma unroll
                    for (int n = 0; n < 2; ++n) s += acc[ai][bj][m][n][0] + acc[ai][bj][m][n][1] + acc[ai][bj][m][n][2] + acc[ai][bj][m][n][3];
        if (s == 1.2345678e-30f) O[u.pm + wr + wc + fr + fq] = 1;
    }
};
struct EpiSwiglu {
    bf16_t* Hd;
    __device__ __forceinline__ void operator()(const Acc& acc, const pg8::Unit& u, int wr, int wc, int fr, int fq) const {
        const int row0 = u.pm * 256 + wr * 64 + fr, col0 = u.pn * 128 + wc * 32 + 8 * fq;
#pragma unroll
        for (int ai = 0; ai < 2; ++ai)
#pragma unroll
            for (int m = 0; m < 4; ++m) { f32x4 v[2];
#pragma unroll
                for (int n = 0; n < 2; ++n)
#pragma unroll
                    for (int j = 0; j < 4; ++j) { const float gt = acc[ai][0][m][n][j]; v[n][j] = gt * sigmoidf_(gt) * acc[ai][1][m][n][j]; }
                store8(Hd + (size_t)(row0 + ai * 128 + m * 16) * DFF + col0, v[0], v[1]); }
    }
};
struct EpiLruIn {
    bf16_t *Y, *U;
    __device__ __forceinline__ void operator()(const Acc& acc, const pg8::Unit& u, int wr, int wc, int fr, int fq) const {
        const int row0 = u.pm * 256 + wr * 64 + fr; const bool isy = u.pn < 6;
        bf16_t* dst = (isy ? Y : U) + (isy ? u.pn : u.pn - 6) * 256 + wc * 32 + 8 * fq;
#pragma unroll
        for (int ai = 0; ai < 2; ++ai)
#pragma unroll
            for (int m = 0; m < 4; ++m) { bf16_t* rowp = dst + (size_t)(row0 + ai * 128 + m * 16) * LW;
#pragma unroll
                for (int bj = 0; bj < 2; ++bj) store8(rowp + bj * 128, acc[ai][bj][m][0], acc[ai][bj][m][1]); }
    }
};
struct EpiGates {
    const bf16_t* UC; const float* gate_b; const float* a_param; bf16_t* LA; bf16_t* Bo;
    __device__ __forceinline__ void operator()(const Acc& acc, const pg8::Unit& u, int wr, int wc, int fr, int fq) const {
        const int row0 = u.pm * 256 + wr * 64 + fr, blk = u.pn >> 1, t = u.pn & 1;
#pragma unroll
        for (int n = 0; n < 2; ++n) {
            const int cloc = 128 * t + wc * 32 + 8 * fq + 4 * n, ch0 = 256 * blk + cloc;
            const f32x4 br = *(const f32x4*)(gate_b + blk * 256 + cloc), bi = *(const f32x4*)(gate_b + (6 + blk) * 256 + cloc), ap = *(const f32x4*)(a_param + ch0);
            f32x4 sp;
#pragma unroll
            for (int j = 0; j < 4; ++j) sp[j] = -8.0f * log1pf(__expf(-ap[j]));
#pragma unroll
            for (int ai = 0; ai < 2; ++ai)
#pragma unroll
                for (int m = 0; m < 4; ++m) { const size_t off = (size_t)(row0 + ai * 128 + m * 16) * LW + ch0;
                    const u32x2 uw = *(const u32x2*)(UC + off);
                    const float uc[4] = {bf_lo(uw.x), bf_hi(uw.x), bf_lo(uw.y), bf_hi(uw.y)};
                    float la[4], bb[4];
#pragma unroll
                    for (int j = 0; j < 4; ++j) {
                        const float r = sigmoidf_(acc[ai][0][m][n][j] + br[j]), ig = sigmoidf_(acc[ai][1][m][n][j] + bi[j]);
                        const float l = r * sp[j]; const float mult = sqrtf(fmaxf(1.0f - __expf(2.0f * l), 0.0f));
                        la[j] = l; bb[j] = mult * ig * uc[j]; }
                    u32x2 o1, o2; o1.x = cvt_pk_bf16(la[0], la[1]); o1.y = cvt_pk_bf16(la[2], la[3]); o2.x = cvt_pk_bf16(bb[0], bb[1]); o2.y = cvt_pk_bf16(bb[2], bb[3]);
                    *(u32x2*)(LA + off) = o1; *(u32x2*)(Bo + off) = o2; }
        }
    }
};

__device__ __forceinline__ void transpose_item(const float* W, int ldw, int k0, int n0, bf16_t* WT, int ldt, int drow0, LAS float* scr, int lane) {
#pragma unroll 8
    for (int i = 0; i < 32; ++i) { const int kk = 2 * i + (lane >> 5); scr[kk * 33 + (lane & 31)] = W[(size_t)(k0 + kk) * ldw + n0 + (lane & 31)]; }
    asm volatile("s_waitcnt lgkmcnt(0)" ::: "memory");
    const int c = lane & 7;
#pragma unroll
    for (int j = 0; j < 4; ++j) { const int n = (lane >> 3) + 8 * j; const LAS float* s = scr + (8 * c) * 33 + n;
        u32x4 o; o.x = cvt_pk_bf16(s[0 * 33], s[1 * 33]); o.y = cvt_pk_bf16(s[2 * 33], s[3 * 33]); o.z = cvt_pk_bf16(s[4 * 33], s[5 * 33]); o.w = cvt_pk_bf16(s[6 * 33], s[7 * 33]);
        *(u32x4*)(WT + (size_t)(drow0 + n) * ldt + k0 + 8 * c) = o; }
    asm volatile("s_waitcnt lgkmcnt(0)" ::: "memory");
}
__device__ __forceinline__ void rms_row_to_bf16(const float* xr, const float* g, bf16_t* orow, int lane) {
    f32x4 v[4]; float s = 0.f;
#pragma unroll
    for (int j = 0; j < 4; ++j) { v[j] = *(const f32x4*)(xr + 256 * j + 4 * lane); s += (v[j][0] * v[j][0] + v[j][1] * v[j][1]) + (v[j][2] * v[j][2] + v[j][3] * v[j][3]); }
    const float rstd = rsqrtf(wave_sum(s) * (1.0f / DM) + EPS);
#pragma unroll
    for (int j = 0; j < 4; ++j) { const f32x4 gg = *(const f32x4*)(g + 256 * j + 4 * lane);
        u32x2 w; w.x = cvt_pk_bf16(v[j][0] * rstd * gg[0], v[j][1] * rstd * gg[1]); w.y = cvt_pk_bf16(v[j][2] * rstd * gg[2], v[j][3] * rstd * gg[3]);
        *(u32x2*)(orow + 256 * j + 4 * lane) = w; }
}

struct Args {
    const float* in[13]; float* out; unsigned char* ws; int ph_lo, ph_hi, coop, pad;
};

__device__ __forceinline__ void phase_prologue(const Args& a, LAS unsigned char* lds, int gw, int NGW, int wave, int lane) {
    LAS float* scr = (LAS float*)(lds + wave * 16384);
    unsigned char* ws = a.ws;
    const float* ret_w_in = a.in[1]; const float* ret_w_out = a.in[2]; const float* lru_w_in = a.in[3]; const float* gate_w = a.in[6];
    const float* lru_w_out = a.in[9]; const float* ffn_w_in = a.in[11]; const float* ffn_w_out = a.in[12];
    constexpr int I0 = 16 * 192, I1 = 32 * 32, I2 = 16 * 96, I3 = 12 * 32, I4 = 24 * 32, I5 = 16 * 176, I6 = 44 * 32;
    constexpr int NITEMS = I0 + I1 + I2 + I3 + I4 + 2 * I5 + 2 * I6;
    for (int it = gw; it < NITEMS; it += NGW) {
        int r = it;
        if (r < I0) { const int kb = r / 192, nb = r % 192; transpose_item(ret_w_in, 6144, 64 * kb, 32 * nb, (bf16_t*)(ws + WS_WRIN), LDW, 32 * nb, scr, lane); continue; } r -= I0;
        if (r < I1) { const int kb = r / 32, nb = r % 32; transpose_item(ret_w_out, 1024, 64 * kb, 32 * nb, (bf16_t*)(ws + WS_WROUT), 2048, 32 * nb, scr, lane); continue; } r -= I1;
        if (r < I2) { const int kb = r / 96, nb = r % 96; transpose_item(lru_w_in, 3072, 64 * kb, 32 * nb, (bf16_t*)(ws + WS_WLIN), LDW, 32 * nb, scr, lane); continue; } r -= I2;
        if (r < I3) { const int mat = r / 32, q = r % 32, kb = q / 8, nb = q % 8, gg = mat / 6, blk = mat % 6, n0 = 32 * nb;
            transpose_item(gate_w + (size_t)mat * 65536, 256, 64 * kb, n0, (bf16_t*)(ws + WS_WG), 256, (2 * blk + n0 / 128) * 256 + 128 * gg + (n0 % 128), scr, lane); continue; } r -= I3;
        if (r < I4) { const int kb = r / 32, nb = r % 32; transpose_item(lru_w_out, 1024, 64 * kb, 32 * nb, (bf16_t*)(ws + WS_WLOUT), 1536, 32 * nb, scr, lane); continue; } r -= I4;
        if (r < 2 * I5) { const int l = r / I5, q = r % I5, kb = q / 176, nb = q % 176, n0 = 32 * nb; const int up = n0 >= DFF, c = up ? n0 - DFF : n0;
            transpose_item(ffn_w_in + (size_t)l * 1024 * 5632, 5632, 64 * kb, n0, (bf16_t*)(ws + WS_WFIN) + (size_t)l * 5632 * LDW, LDW, 256 * (c / 128) + 128 * up + (c % 128), scr, lane); continue; } r -= 2 * I5;
        { const int l = r / I6, q = r % I6, kb = q / 32, nb = q % 32;
            transpose_item(ffn_w_out + (size_t)l * DFF * 1024, 1024, 64 * kb, 32 * nb, (bf16_t*)(ws + WS_WFOUT) + (size_t)l * 1024 * DFF, DFF, 32 * nb, scr, lane); }
    }
    const float* x = a.in[0]; const float* ng = a.in[10]; bf16_t* H = (bf16_t*)(ws + WS_H);
    for (int m = gw; m < MTOK; m += NGW) rms_row_to_bf16(x + (size_t)m * DM, ng, H + (size_t)m * LDH, lane);
}

template <bool XB, bool OB>
__device__ __forceinline__ void phase_norm_res(const void* xold_, const bf16_t* Mb, const float* gpost, const float* gnext, void* out_, bf16_t* H, int gw, int NGW, int lane) {
    for (int r0 = gw; r0 < MTOK; r0 += 2 * NGW) {
        float mv[2][16], xv[2][16];
#pragma unroll
        for (int q = 0; q < 2; ++q) { const int r = r0 + q * NGW; const bf16_t* mr = Mb + (size_t)r * LDH;
#pragma unroll
            for (int h = 0; h < 2; ++h) { const u32x4 w = *(const u32x4*)(mr + 512 * h + 8 * lane);
                mv[q][8 * h + 0] = bf_lo(w.x); mv[q][8 * h + 1] = bf_hi(w.x); mv[q][8 * h + 2] = bf_lo(w.y); mv[q][8 * h + 3] = bf_hi(w.y);
                mv[q][8 * h + 4] = bf_lo(w.z); mv[q][8 * h + 5] = bf_hi(w.z); mv[q][8 * h + 6] = bf_lo(w.w); mv[q][8 * h + 7] = bf_hi(w.w);
                if constexpr (XB) { const u32x4 xw = *(const u32x4*)((const bf16_t*)xold_ + (size_t)r * DM + 512 * h + 8 * lane);
                    xv[q][8 * h + 0] = bf_lo(xw.x); xv[q][8 * h + 1] = bf_hi(xw.x); xv[q][8 * h + 2] = bf_lo(xw.y); xv[q][8 * h + 3] = bf_hi(xw.y);
                    xv[q][8 * h + 4] = bf_lo(xw.z); xv[q][8 * h + 5] = bf_hi(xw.z); xv[q][8 * h + 6] = bf_lo(xw.w); xv[q][8 * h + 7] = bf_hi(xw.w);
                } else { const float* xr = (const float*)xold_ + (size_t)r * DM;
                    const f32x4 x0 = *(const f32x4*)(xr + 512 * h + 8 * lane), x1 = *(const f32x4*)(xr + 512 * h + 8 * lane + 4);
#pragma unroll
                    for (int j = 0; j < 4; ++j) { xv[q][8 * h + j] = x0[j]; xv[q][8 * h + 4 + j] = x1[j]; } } } }
        f32x4 gp[4];
#pragma unroll
        for (int h = 0; h < 2; ++h) { gp[2 * h] = *(const f32x4*)(gpost + 512 * h + 8 * lane); gp[2 * h + 1] = *(const f32x4*)(gpost + 512 * h + 8 * lane + 4); }
        float rs2[2];
#pragma unroll
        for (int q = 0; q < 2; ++q) { const int r = r0 + q * NGW;
            float s = 0.f;
#pragma unroll
            for (int k = 0; k < 16; ++k) s += mv[q][k] * mv[q][k];
            const float rstd = rsqrtf(wave_sum(s) * (1.0f / DM) + EPS);
            float s2 = 0.f;
#pragma unroll
            for (int h = 0; h < 2; ++h) {
#pragma unroll
                for (int j = 0; j < 4; ++j) { xv[q][8 * h + j] += mv[q][8 * h + j] * rstd * gp[2 * h][j]; xv[q][8 * h + 4 + j] += mv[q][8 * h + 4 + j] * rstd * gp[2 * h + 1][j]; }
                if constexpr (OB) store8((bf16_t*)out_ + (size_t)r * DM + 512 * h + 8 * lane, (f32x4){xv[q][8 * h], xv[q][8 * h + 1], xv[q][8 * h + 2], xv[q][8 * h + 3]}, (f32x4){xv[q][8 * h + 4], xv[q][8 * h + 5], xv[q][8 * h + 6], xv[q][8 * h + 7]});
                else { float* orow = (float*)out_ + (size_t)r * DM;
                    *(f32x4*)(orow + 512 * h + 8 * lane) = (f32x4){xv[q][8 * h], xv[q][8 * h + 1], xv[q][8 * h + 2], xv[q][8 * h + 3]};
                    *(f32x4*)(orow + 512 * h + 8 * lane + 4) = (f32x4){xv[q][8 * h + 4], xv[q][8 * h + 5], xv[q][8 * h + 6], xv[q][8 * h + 7]}; } }
#pragma unroll
            for (int k = 0; k < 16; ++k) s2 += xv[q][k] * xv[q][k];
            rs2[q] = s2; }
        if (gnext) {
            f32x4 gn[4];
#pragma unroll
            for (int h = 0; h < 2; ++h) { gn[2 * h] = *(const f32x4*)(gnext + 512 * h + 8 * lane); gn[2 * h + 1] = *(const f32x4*)(gnext + 512 * h + 8 * lane + 4); }
#pragma unroll
            for (int q = 0; q < 2; ++q) { const int r = r0 + q * NGW;
                const float rstd2 = rsqrtf(wave_sum(rs2[q]) * (1.0f / DM) + EPS);
                bf16_t* hr = H + (size_t)r * LDH;
#pragma unroll
                for (int h = 0; h < 2; ++h) { f32x4 v0, v1;
#pragma unroll
                    for (int j = 0; j < 4; ++j) { v0[j] = xv[q][8 * h + j] * rstd2 * gn[2 * h][j]; v1[j] = xv[q][8 * h + 4 + j] * rstd2 * gn[2 * h + 1][j]; }
                    store8(hr + 512 * h + 8 * lane, v0, v1); } }
        }
    }
}

__device__ __forceinline__ bf16x8 tr_frag(const LAS unsigned char* p0, const LAS unsigned char* p1) {
    const s16x4 a = __builtin_amdgcn_ds_read_tr16_b64_v4i16((LAS s16x4*)p0);
    const s16x4 b = __builtin_amdgcn_ds_read_tr16_b64_v4i16((LAS s16x4*)p1);
    return __builtin_shufflevector(a, b, 0, 1, 2, 3, 4, 5, 6, 7);
}
__device__ __forceinline__ void phase_r1(LAS unsigned char* lds, const bf16_t* Kb, const bf16_t* Vb, bf16_t* ST, int G, int bid) {
    const int tid = threadIdx.x, w = __builtin_amdgcn_readfirstlane(tid >> 6), lane = tid & 63, li = lane & 15, g4 = lane >> 4, q4 = (lane & 15) >> 2, p4 = lane & 3;
    constexpr int KSTR = 544, VSTR = 96;
    LAS unsigned char* LK = lds; LAS unsigned char* LV = lds + 128 * KSTR;
    for (int unit = bid; unit < 256; unit += G) {
        const int xcd_ = unit & 7, j_ = unit >> 3, bh = xcd_ * 2 + (j_ >> 4), es = j_ & 15, b = bh >> 2, h = bh & 3;
        const float lg2 = log2f(1.0f - exp2f(-5.0f - (float)h));
        const float cd = exp2f(128.0f * lg2);
        const bf16_t* kbase = Kb + (size_t)(b * SEQ) * 1024 + h * 256;
        const bf16_t* vbase = Vb + (size_t)(b * SEQ) * 2048 + h * 512 + es * 32;
        const int vrow = tid >> 2, vc = tid & 3;
        const float kd = exp2f((float)(127 - vrow) * lg2);
        f32x4 S[2][2];
#pragma unroll
        for (int i = 0; i < 2; ++i)
#pragma unroll
            for (int j = 0; j < 2; ++j) S[i][j] = (f32x4){0.f, 0.f, 0.f, 0.f};
        u32x4 kr[2][8], vr[2];
#define R1_LOAD(buf, n_) do { const size_t ro_ = (size_t)(n_) * 128; \
        _Pragma("unroll") for (int i = 0; i < 8; ++i) { const int piece = tid + 512 * i; kr[buf][i] = *(const u32x4*)(kbase + (ro_ + (piece >> 5)) * 1024 + (piece & 31) * 8); } \
        vr[buf] = *(const u32x4*)(vbase + (ro_ + vrow) * 2048 + vc * 8); } while (0)
#define R1_STORE(np_) do { bf16_t* st = ST + ((size_t)(bh * 32 + (np_)) * 512) * 256; \
        _Pragma("unroll") for (int dt = 0; dt < 2; ++dt) _Pragma("unroll") for (int et = 0; et < 2; ++et) { const int e = 32 * es + 16 * et + li, d = 32 * w + 16 * dt + 4 * g4; \
            u32x2 o; o.x = cvt_pk_bf16(S[dt][et][0], S[dt][et][1]); o.y = cvt_pk_bf16(S[dt][et][2], S[dt][et][3]); *(u32x2*)(st + (size_t)e * 256 + d) = o; } } while (0)
#define R1_STEP(buf, n_) do { \
        __syncthreads(); \
        _Pragma("unroll") for (int i = 0; i < 8; ++i) { const int piece = tid + 512 * i; *(LAS u32x4*)(LK + (piece >> 5) * KSTR + (piece & 31) * 16) = kr[buf][i]; } \
        { const u32x4 v_ = vr[buf]; u32x4 o; o.x = cvt_pk_bf16(bf_lo(v_.x) * kd, bf_hi(v_.x) * kd); o.y = cvt_pk_bf16(bf_lo(v_.y) * kd, bf_hi(v_.y) * kd); \
          o.z = cvt_pk_bf16(bf_lo(v_.z) * kd, bf_hi(v_.z) * kd); o.w = cvt_pk_bf16(bf_lo(v_.w) * kd, bf_hi(v_.w) * kd); *(LAS u32x4*)(LV + vrow * VSTR + vc * 16) = o; } \
        __syncthreads(); \
        if ((n_) + 2 < 62) R1_LOAD(buf, (n_) + 2); \
        if (((n_) & 1) == 0) R1_STORE((n_) >> 1); \
        _Pragma("unroll") for (int i = 0; i < 2; ++i) _Pragma("unroll") for (int j = 0; j < 2; ++j) S[i][j] *= cd; \
        _Pragma("unroll") for (int ks = 0; ks < 4; ++ks) { const int row0_ = 32 * ks + 8 * g4 + q4; bf16x8 af[2], bfr[2]; \
            _Pragma("unroll") for (int dt = 0; dt < 2; ++dt) { const LAS unsigned char* p = LK + row0_ * KSTR + (32 * w + 16 * dt + 4 * p4) * 2; af[dt] = tr_frag(p, p + 4 * KSTR); } \
            _Pragma("unroll") for (int et = 0; et < 2; ++et) { const LAS unsigned char* p = LV + row0_ * VSTR + (16 * et + 4 * p4) * 2; bfr[et] = tr_frag(p, p + 4 * VSTR); } \
            _Pragma("unroll") for (int dt = 0; dt < 2; ++dt) _Pragma("unroll") for (int et = 0; et < 2; ++et) S[dt][et] = __builtin_amdgcn_mfma_f32_16x16x32_bf16(af[dt], bfr[et], S[dt][et], 0, 0, 0); } \
    } while (0)
        R1_LOAD(0, 0); R1_LOAD(1, 1);
        for (int n = 0; n < 62; n += 2) { R1_STEP(0, n); R1_STEP(1, n + 1); }
        R1_STORE(31);
        __syncthreads();
#undef R1_LOAD
#undef R1_STORE
#undef R1_STEP
    }
}

struct R2Unit { int r, bh, np, b, h, row0, nst; float lg2; };
__device__ __forceinline__ bool r2_decode(int i, int G, int bid, R2Unit& u) {
    const int unit = bid + G * i; if (unit >= 2048) return false;
    const int w_ = unit % G, i_ = unit / G, xcd_ = w_ & 7, j_ = w_ >> 3;
    int rest = (i_ * 64 + xcd_ * 8 + (j_ >> 2)) & 511; u.r = (j_ + i_) & 3;
    if (G != 256) { u.r = (unit >> 8) & 3; rest = (unit & 255) | ((unit >> 10) << 8); }
    u.bh = rest >> 5; u.np = rest & 31; u.b = u.bh >> 2; u.h = u.bh & 3;
    u.row0 = u.b * SEQ + u.np * 256 + u.r * 64; u.nst = (u.np > 0 ? 4 : 0) + u.r + 1; u.lg2 = log2f(1.0f - exp2f(-5.0f - (float)u.h)); return true;
}
__device__ __forceinline__ void phase_r2(LAS unsigned char* lds, const bf16_t* Qb, const bf16_t* Kb, const bf16_t* Vb, bf16_t* Gb, const bf16_t* ST, int G, int bid, bf16_t* Gout, int rowmask) {
    const int tid = threadIdx.x, w = __builtin_amdgcn_readfirstlane(tid >> 6), lane = tid & 63, li = lane & 15, g4 = lane >> 4, q4 = (lane & 15) >> 2, p4 = lane & 3;
    constexpr int QSTR = 528, VSTR = 1056, PSTR = 144, SSTR = 144;
    LAS unsigned char* LQ = lds; LAS unsigned char* LK = lds + 33792; LAS unsigned char* LV = LK + 33792; LAS unsigned char* LP = LV + 67584; LAS unsigned char* LS = LK;
    R2Unit cu, nu; int ui = 0, cs = 0;
    if (!r2_decode(0, G, bid, cu)) return;
    u32x4 pf[12];
    f32x4 acc[4][4];
    const unsigned voV = (unsigned)((tid >> 6) * 4096 + (tid & 63) * 16), voK = (unsigned)((tid >> 5) * 2048 + (tid & 31) * 16), voS = (unsigned)((tid >> 3) * 512 + (tid & 7) * 16);
#define R2_PREFETCH(u_, s_) do { const int nstS_ = (u_).np > 0 ? 4 : 0; \
        if ((s_) < nstS_) { const char* stb = (const char*)(ST + ((size_t)((u_).bh * 32 + (u_).np) * 512) * 256 + (s_) * 64); \
            _Pragma("unroll") for (int i = 0; i < 8; ++i) pf[i] = *(const u32x4*)(stb + (size_t)i * 32768 + voS); } \
        else { const int key0 = (u_).b * SEQ + (u_).np * 256 + ((s_) - nstS_) * 64; \
            const char* vb_ = (const char*)(Vb + (size_t)key0 * 2048 + (u_).h * 512); const char* kb_ = (const char*)(Kb + (size_t)key0 * 1024 + (u_).h * 256); \
            _Pragma("unroll") for (int i = 0; i < 8; ++i) pf[i] = *(const u32x4*)(vb_ + (size_t)i * 32768 + voV); \
            _Pragma("unroll") for (int i = 0; i < 4; ++i) pf[8 + i] = *(const u32x4*)(kb_ + (size_t)i * 32768 + voK); } \
        if ((s_) == 0 && nstS_ > 0) { const char* qb_ = (const char*)(Qb + (size_t)(u_).row0 * 1024 + (u_).h * 256); \
            _Pragma("unroll") for (int i = 0; i < 4; ++i) pf[8 + i] = *(const u32x4*)(qb_ + (size_t)i * 32768 + voK); } \
    } while (0)
    R2_PREFETCH(cu, 0);
    for (;;) {
        const int nstS = cu.np > 0 ? 4 : 0; const bool isS = cs < nstS;
        __syncthreads();
        if (isS) {
#pragma unroll
            for (int i = 0; i < 8; ++i) *(LAS u32x4*)(LS + ((tid >> 3) * SSTR + (tid & 7) * 16) + i * 64 * SSTR) = pf[i];
        } else {
#pragma unroll
            for (int i = 0; i < 8; ++i) *(LAS u32x4*)(LV + ((tid >> 6) * VSTR + (tid & 63) * 16) + i * 8 * VSTR) = pf[i];
#pragma unroll
            for (int i = 0; i < 4; ++i) *(LAS u32x4*)(LK + ((tid >> 5) * QSTR + (tid & 31) * 16) + i * 16 * QSTR) = pf[8 + i];
        }
        if (cs == 0) {
#pragma unroll
            for (int i = 0; i < 4; ++i) { u32x4 qv = pf[8 + i];
                if (nstS == 0) qv = *(const u32x4*)((const char*)(Qb + (size_t)cu.row0 * 1024 + cu.h * 256) + (size_t)i * 32768 + voK);
                *(LAS u32x4*)(LQ + ((tid >> 5) * QSTR + (tid & 31) * 16) + i * 16 * QSTR) = qv; }
#pragma unroll
            for (int i = 0; i < 4; ++i)
#pragma unroll
                for (int j = 0; j < 4; ++j) acc[i][j] = (f32x4){0.f, 0.f, 0.f, 0.f};
        }
        __syncthreads();
        bool have_next = true; int ns = cs + 1; const bool last_stage = (ns == cu.nst);
        if (last_stage) { have_next = r2_decode(ui + 1, G, bid, nu); ns = 0; } else nu = cu;
        if (have_next) R2_PREFETCH(nu, ns);
        if (isS) {
#pragma unroll 1
            for (int ks = 0; ks < 2; ++ks) {
                bf16x8 qf[4], sf[4];
#pragma unroll
                for (int it = 0; it < 4; ++it) qf[it] = *(const LAS bf16x8*)(LQ + (16 * it + li) * QSTR + (cs * 64 + ks * 32 + 8 * g4) * 2);
#pragma unroll
                for (int et = 0; et < 4; ++et) sf[et] = *(const LAS bf16x8*)(LS + (64 * w + 16 * et + li) * SSTR + (ks * 32 + 8 * g4) * 2);
#pragma unroll
                for (int et = 0; et < 4; ++et)
#pragma unroll
                    for (int it = 0; it < 4; ++it) acc[et][it] = __builtin_amdgcn_mfma_f32_16x16x32_bf16(sf[et], qf[it], acc[et][it], 0, 0, 0);
            }
            if (cs == 3) {
#pragma unroll
                for (int it = 0; it < 4; ++it) { const float s = exp2f((float)(64 * cu.r + 16 * it + li + 1) * cu.lg2);
#pragma unroll
                    for (int et = 0; et < 4; ++et) acc[et][it] *= s; }
            }
        } else {
            const int jb = cs - nstS;
            {
                const int it = w >> 1, jt0 = (w & 1) * 2;
                f32x4 pa[2] = {(f32x4){0.f, 0.f, 0.f, 0.f}, (f32x4){0.f, 0.f, 0.f, 0.f}};
#pragma unroll 2
                for (int ks = 0; ks < 8; ++ks) {
                    const bf16x8 qf = *(const LAS bf16x8*)(LQ + (16 * it + li) * QSTR + (ks * 32 + 8 * g4) * 2);
#pragma unroll
                    for (int jj = 0; jj < 2; ++jj) { const bf16x8 kf = *(const LAS bf16x8*)(LK + (16 * (jt0 + jj) + li) * QSTR + (ks * 32 + 8 * g4) * 2);
                        pa[jj] = __builtin_amdgcn_mfma_f32_16x16x32_bf16(kf, qf, pa[jj], 0, 0, 0); }
                }
                const int iq = 64 * cu.r + 16 * it + li;
#pragma unroll
                for (int jj = 0; jj < 2; ++jj) { const int jk0 = 64 * jb + 16 * (jt0 + jj) + 4 * g4; float pv[4];
#pragma unroll
                    for (int e = 0; e < 4; ++e) { const int dist = iq - (jk0 + e); pv[e] = dist >= 0 ? pa[jj][e] * exp2f((float)dist * cu.lg2) : 0.0f; }
                    u32x2 o; o.x = cvt_pk_bf16(pv[0], pv[1]); o.y = cvt_pk_bf16(pv[2], pv[3]);
                    *(LAS u32x2*)(LP + (16 * it + li) * PSTR + (16 * (jt0 + jj) + 4 * g4) * 2) = o; }
            }
            __syncthreads();
#pragma unroll 1
            for (int ks = 0; ks < 2; ++ks) {
                bf16x8 pfr[4], vf[4];
#pragma unroll
                for (int it = 0; it < 4; ++it) pfr[it] = *(const LAS bf16x8*)(LP + (16 * it + li) * PSTR + (ks * 32 + 8 * g4) * 2);
                const int vrow = 32 * ks + 8 * g4 + q4;
#pragma unroll
                for (int et = 0; et < 4; ++et) { const LAS unsigned char* p = LV + vrow * VSTR + (64 * w + 16 * et + 4 * p4) * 2; vf[et] = tr_frag(p, p + 4 * VSTR); }
#pragma unroll
                for (int et = 0; et < 4; ++et)
#pragma unroll
                    for (int it = 0; it < 4; ++it) acc[et][it] = __builtin_amdgcn_mfma_f32_16x16x32_bf16(vf[et], pfr[it], acc[et][it], 0, 0, 0);
            }
        }
        if (last_stage) {
            float s1[4], s2[4];
#pragma unroll
            for (int it = 0; it < 4; ++it) { float a1 = 0.f, a2 = 0.f;
#pragma unroll
                for (int et = 0; et < 4; ++et)
#pragma unroll
                    for (int e = 0; e < 4; ++e) { const float v = acc[et][it][e]; a1 += v; a2 += v * v; }
                a1 += __shfl_xor(a1, 16); a1 += __shfl_xor(a1, 32); a2 += __shfl_xor(a2, 16); a2 += __shfl_xor(a2, 32);
                s1[it] = a1; s2[it] = a2; }
            __syncthreads();
            LAS f32x2* red = (LAS f32x2*)LP;
            if (g4 == 0) {
#pragma unroll
                for (int it = 0; it < 4; ++it) red[(16 * it + li) * 8 + w] = (f32x2){s1[it], s2[it]};
            }
            __syncthreads();
#pragma unroll
            for (int it = 0; it < 4; ++it) { float a1 = 0.f, a2 = 0.f;
#pragma unroll
                for (int k = 0; k < 8; ++k) { const f32x2 t = red[(16 * it + li) * 8 + k]; a1 += t[0]; a2 += t[1]; }
                const float mu = a1 * (1.0f / 512.0f); const float var = fmaxf(a2 * (1.0f / 512.0f) - mu * mu, 0.0f); const float rstd = rsqrtf(var + EPS);
                bf16_t* grow = Gb + (size_t)(cu.row0 + 16 * it + li) * 2048 + cu.h * 512 + 64 * w + 4 * g4;
#pragma unroll
                for (int et = 0; et < 4; ++et) { const u32x2 gw2 = *(const u32x2*)(grow + 16 * et);
                    const float g0 = bf_lo(gw2.x), g1 = bf_hi(gw2.x), g2 = bf_lo(gw2.y), g3 = bf_hi(gw2.y);
                    const float o0 = (acc[et][it][0] - mu) * rstd * g0 * sigmoidf_(g0), o1 = (acc[et][it][1] - mu) * rstd * g1 * sigmoidf_(g1);
                    const float o2 = (acc[et][it][2] - mu) * rstd * g2 * sigmoidf_(g2), o3 = (acc[et][it][3] - mu) * rstd * g3 * sigmoidf_(g3);
                    u32x2 o; o.x = cvt_pk_bf16(o0, o1); o.y = cvt_pk_bf16(o2, o3);
                    *(u32x2*)(Gout + (size_t)((cu.row0 + 16 * it + li) & rowmask) * 2048 + cu.h * 512 + 64 * w + 4 * g4 + 16 * et) = o; }
                asm volatile("" ::: "memory");
            }
            if (!have_next) break;
            ++ui;
        }
        cu = nu; cs = ns;
    }
#undef R2_PREFETCH
    __syncthreads();
}

__device__ __forceinline__ void unpack8(const u32x4 w, float* f) { f[0] = bf_lo(w.x); f[1] = bf_hi(w.x); f[2] = bf_lo(w.y); f[3] = bf_hi(w.y); f[4] = bf_lo(w.z); f[5] = bf_hi(w.z); f[6] = bf_lo(w.w); f[7] = bf_hi(w.w); }
__device__ __forceinline__ void phase_conv(const bf16_t* U, const float* cw, const float* cb, bf16_t* UC, int G, int bid) {
    for (int unit = bid; unit < 768; unit += G) {
        const int idx = unit * 512 + threadIdx.x, cg8 = idx % 192, tb = idx / 192, c0 = cg8 * 8, row0 = tb * 16;
        const bool first = (row0 & (SEQ - 1)) == 0;
        u32x4 ur[19];
#pragma unroll
        for (int k = 0; k < 19; ++k) { if (k < 3 && first) ur[k] = (u32x4){0u, 0u, 0u, 0u}; else ur[k] = *(const u32x4*)(U + (size_t)(row0 - 3 + k) * LW + c0); }
        float w[4][8], bias[8];
#pragma unroll
        for (int j = 0; j < 4; ++j) { const f32x4 w0 = *(const f32x4*)(cw + j * LW + c0), w1 = *(const f32x4*)(cw + j * LW + c0 + 4);
#pragma unroll
            for (int k = 0; k < 4; ++k) { w[j][k] = w0[k]; w[j][4 + k] = w1[k]; } }
        { const f32x4 b0 = *(const f32x4*)(cb + c0), b1 = *(const f32x4*)(cb + c0 + 4);
#pragma unroll
          for (int k = 0; k < 4; ++k) { bias[k] = b0[k]; bias[4 + k] = b1[k]; } }
#pragma unroll
        for (int t = 0; t < 16; ++t) { float av[8];
#pragma unroll
            for (int k = 0; k < 8; ++k) av[k] = bias[k];
#pragma unroll
            for (int j = 0; j < 4; ++j) { float f[8]; unpack8(ur[t + j], f);
#pragma unroll
                for (int k = 0; k < 8; ++k) av[k] += w[j][k] * f[k]; }
            u32x4 o; o.x = cvt_pk_bf16(av[0], av[1]); o.y = cvt_pk_bf16(av[2], av[3]); o.z = cvt_pk_bf16(av[4], av[5]); o.w = cvt_pk_bf16(av[6], av[7]);
            *(u32x4*)(UC + (size_t)(row0 + t) * LW + c0) = o; }
    }
}
__device__ __forceinline__ void phase_scan1(const bf16_t* LA, const bf16_t* Bv, f32x2* Hc, f32x2* Lc, int G, int bid) {
    for (int unit = bid; unit < 768; unit += G) {
        const int idx = unit * 512 + threadIdx.x, cp = idx % 768, bc = idx / 768;
        const size_t base = (size_t)bc * 64 * LW + 2 * cp;
        float h0 = 0.f, h1 = 0.f, L0 = 0.f, L1 = 0.f;
        for (int t0 = 0; t0 < 64; t0 += 16) { unsigned la[16], bb[16];
#pragma unroll
            for (int k = 0; k < 16; ++k) { la[k] = *(const unsigned*)(LA + base + (size_t)(t0 + k) * LW); bb[k] = *(const unsigned*)(Bv + base + (size_t)(t0 + k) * LW); }
#pragma unroll
            for (int k = 0; k < 16; ++k) { const float l0 = bf_lo(la[k]), l1 = bf_hi(la[k]); h0 = __expf(l0) * h0 + bf_lo(bb[k]); h1 = __expf(l1) * h1 + bf_hi(bb[k]); L0 += l0; L1 += l1; } }
        Hc[idx] = (f32x2){h0, h1}; Lc[idx] = (f32x2){L0, L1};
    }
}
__device__ __forceinline__ void phase_scan2(const bf16_t* LA, const bf16_t* Bv, const f32x2* Hc, const f32x2* Lc, bf16_t* Y, int G, int bid) {
    for (int unit = bid; unit < 768; unit += G) {
        const int idx = unit * 512 + threadIdx.x, cp = idx % 768, bc = idx / 768, c = bc & 127, b = bc >> 7;
        float h0 = 0.f, h1 = 0.f;
        const f32x2* hp = Hc + (size_t)(b * 128) * 768 + cp; const f32x2* lp = Lc + (size_t)(b * 128) * 768 + cp;
        int cc = 0;
        for (; cc + 8 <= c; cc += 8) { f32x2 hh[8], ll[8];
#pragma unroll
            for (int k = 0; k < 8; ++k) { hh[k] = hp[(size_t)(cc + k) * 768]; ll[k] = lp[(size_t)(cc + k) * 768]; }
#pragma unroll
            for (int k = 0; k < 8; ++k) { h0 = __expf(ll[k][0]) * h0 + hh[k][0]; h1 = __expf(ll[k][1]) * h1 + hh[k][1]; } }
        for (; cc < c; ++cc) { const f32x2 hh = hp[(size_t)cc * 768], ll = lp[(size_t)cc * 768]; h0 = __expf(ll[0]) * h0 + hh[0]; h1 = __expf(ll[1]) * h1 + hh[1]; }
        const size_t base = (size_t)bc * 64 * LW + 2 * cp;
        for (int t0 = 0; t0 < 64; t0 += 16) { unsigned la[16], bb[16], yy[16];
#pragma unroll
            for (int k = 0; k < 16; ++k) { const size_t o = base + (size_t)(t0 + k) * LW; la[k] = *(const unsigned*)(LA + o); bb[k] = *(const unsigned*)(Bv + o); yy[k] = *(const unsigned*)(Y + o); }
#pragma unroll
            for (int k = 0; k < 16; ++k) { h0 = __expf(bf_lo(la[k])) * h0 + bf_lo(bb[k]); h1 = __expf(bf_hi(la[k])) * h1 + bf_hi(bb[k]);
                const float y0 = bf_lo(yy[k]), y1 = bf_hi(yy[k]);
                const float z0 = 1.5957691216057308f * (y0 + 0.044715f * y0 * y0 * y0), z1 = 1.5957691216057308f * (y1 + 0.044715f * y1 * y1 * y1);
                *(unsigned*)(Y + base + (size_t)(t0 + k) * LW) = cvt_pk_bf16(h0 * y0 * sigmoidf_(z0), h1 * y1 * sigmoidf_(z1)); } }
    }
}

#define XB_TMO      128
#define XB_XCNT(j)  (256  + 64 * (j))
#define XB_XSUB(j)  (1280 + 64 * (j))
#define XB_XGEN(j)  (2304 + 64 * (j))
#define XB_TOP      3328
#define XB_TOPGEN   3392
#define XCD_BAR_WORDS 3456
#define XB_SPIN_CAP (1u << 20)
__device__ __forceinline__ unsigned xb_ld(unsigned* p)              { return __hip_atomic_load(p, __ATOMIC_RELAXED, __HIP_MEMORY_SCOPE_AGENT); }
__device__ __forceinline__ unsigned xb_add(unsigned* p, unsigned v) { return __hip_atomic_fetch_add(p, v, __ATOMIC_RELAXED, __HIP_MEMORY_SCOPE_AGENT); }
__device__ __forceinline__ unsigned xb_xcc_id() { return (unsigned)__builtin_amdgcn_s_getreg((3 << 11) | 20) & 0xFu; }
#define XB_SPIN(cond, bar) do { unsigned _sp = 0; while (cond) { __builtin_amdgcn_s_sleep(1); \
    if ((++_sp & 255u) == 0u) { if (xb_ld(&(bar)[XB_TMO])) break; if (_sp > XB_SPIN_CAP) { atomicAdd(&(bar)[XB_TMO], 1u); break; } } } } while (0)
struct XcdBarrier { unsigned* bar; unsigned x; volatile LAS unsigned* st; };
__device__ __forceinline__ XcdBarrier xcd_barrier_post(unsigned* bar, volatile LAS unsigned* st) {
    XcdBarrier b; b.bar = bar; b.x = xb_xcc_id(); b.st = st;
    if (threadIdx.x == 0) (void)xb_add(&bar[XB_XCNT(b.x)], 1u);
    return b;
}
__device__ __forceinline__ void xcd_barrier_complete(unsigned* bar, unsigned x, unsigned& nloc, unsigned& nx) {
    const unsigned G = gridDim.x * gridDim.y * gridDim.z;
    unsigned sum, cnt, mine, sp = 0u;
    for (;;) {
        sum = 0u; cnt = 0u; mine = 0u;
#pragma unroll
        for (unsigned j = 0; j < 16; ++j) { const unsigned c = xb_ld(&bar[XB_XCNT(j)]); sum += c; cnt += (c > 0u) ? 1u : 0u; mine = (j == x) ? c : mine; }
        if (sum == G) break;
        __builtin_amdgcn_s_sleep(1);
        if ((++sp & 255u) == 0u) { if (xb_ld(&bar[XB_TMO])) break; if (sp > XB_SPIN_CAP) { atomicAdd(&bar[XB_TMO], 1u); break; } }
    }
    nloc = mine > 0u ? mine : 1u; nx = cnt > 0u ? cnt : 1u;
}
__device__ __forceinline__ void xcd_barrier(const XcdBarrier& b) {
    asm volatile("s_waitcnt vmcnt(0)" ::: "memory");
    __syncthreads();
    if (threadIdx.x == 0) {
        unsigned* bar = b.bar;
        __builtin_amdgcn_s_waitcnt(0);
        unsigned nloc = b.st[0], nx = b.st[1];
        if (nloc == 0u) { xcd_barrier_complete(bar, b.x, nloc, nx); b.st[0] = nloc; b.st[1] = nx; }
        const unsigned old = xb_add(&bar[XB_XSUB(b.x)], 1u);
        const unsigned gen = old / nloc;
        if (old + 1u == (gen + 1u) * nloc) {
            __builtin_amdgcn_fence(__ATOMIC_RELEASE, "agent");
            asm volatile("s_waitcnt vmcnt(0)" ::: "memory");
            const unsigned og = xb_add(&bar[XB_TOP], 1u);
            const unsigned tg = og / nx;
            if (og + 1u == (tg + 1u) * nx) xb_add(&bar[XB_TOPGEN], 1u);
            else XB_SPIN(xb_ld(&bar[XB_TOPGEN]) == tg, bar);
            __builtin_amdgcn_fence(__ATOMIC_ACQUIRE, "agent");
            xb_add(&bar[XB_XGEN(b.x)], 1u);
            asm volatile("s_waitcnt vmcnt(0)" ::: "memory");
        } else {
            XB_SPIN(xb_ld(&bar[XB_XGEN(b.x)]) == gen, bar);
            __builtin_amdgcn_fence(__ATOMIC_ACQUIRE, "agent");
            asm volatile("s_waitcnt vmcnt(0)" ::: "memory");
        }
    }
    __syncthreads();
}

__global__ void __launch_bounds__(512) fwd_megakernel(Args a) {
    extern __shared__ __attribute__((aligned(16))) unsigned char lds_raw[];
    LAS unsigned char* lds = (LAS unsigned char*)lds_raw;
    cg::grid_group grid = cg::this_grid();
    const int tid = threadIdx.x, lane = tid & 63, wave = __builtin_amdgcn_readfirstlane(tid >> 6);
    const int G = gridDim.x, bid = blockIdx.x;
    const int gw = bid * 8 + wave, NGW = G * 8;
    unsigned char* ws = a.ws;
    const float* x = a.in[0]; const float* conv_w = a.in[4]; const float* conv_b = a.in[5]; const float* gate_b = a.in[7]; const float* a_param = a.in[8];
    const float* ng = a.in[10];
    bf16_t* H = (bf16_t*)(ws + WS_H);
    bf16_t* Qb = (bf16_t*)(ws + WS_Q); bf16_t* Kb = (bf16_t*)(ws + WS_K); bf16_t* Vb = (bf16_t*)(ws + WS_V); bf16_t* Gb = (bf16_t*)(ws + WS_G);
    bf16_t* ST = (bf16_t*)a.out;
    bf16_t* Y = (bf16_t*)(ws + WS_Y); bf16_t* U = (bf16_t*)(ws + WS_U); bf16_t* UC = (bf16_t*)(ws + WS_UC); bf16_t* Bv = (bf16_t*)a.out;     bf16_t* XB = (bf16_t*)(ws + WS_XB); bf16_t* LA = U;
    f32x2* Hc = (f32x2*)(ws + WS_H); f32x2* Lc = Hc + 4 * 128 * 768;
    const int lo = a.ph_lo, hi = a.ph_hi;
    volatile LAS unsigned* bst = (volatile LAS unsigned*)(lds + LDS_BYTES - 64);
    if (tid == 0) { bst[0] = 0u; bst[1] = 0u; }
    __syncthreads();
    XcdBarrier xbar; xbar.bar = (unsigned*)(ws + WS_SCAN); xbar.x = 0; xbar.st = bst;
    if (a.coop) xbar = xcd_barrier_post((unsigned*)(ws + WS_SCAN), bst);
#ifndef PHMASK
#define PHMASK 0x7ffff
#endif
#define IN(k) (((PHMASK >> (k)) & 1) && lo <= (k) && (k) < hi)
#define SEAM(k) do { if (a.coop && IN((k) + 1)) { if ((k) == 0) grid.sync(); else xcd_barrier(xbar); } } while (0)
#ifndef REPMASK
#define REPMASK 0
#endif
#ifndef STAGGER_TICKS
#define STAGGER_TICKS 0u
#endif
#define REP(k, stmt) do { stmt; if ((REPMASK >> (k)) & 1) { stmt; } } while (0)
    pg8::StaticOrder S;
    if (IN(0)) { REP(0, phase_prologue(a, lds, gw, NGW, wave, lane_id_fresh())); SEAM(0); }
    if (IN(1)) { pg8::Gemm g{H, (const bf16_t*)(ws + WS_WRIN), MTOK, 6144, 1024, LDH, LDW, 1 << 20, 0}; S.init(MTOK, 6144, G, bid);
        EpiRetIn E{Qb, Kb, Vb, Gb}; pg8::gemm_phase(lds, g, S, E, STAGGER_TICKS); if ((REPMASK >> 1) & 1) { EpiNull E0{H}; pg8::gemm_phase(lds, g, S, E0, STAGGER_TICKS); } SEAM(1); }
    if (IN(2)) { REP(2, phase_r1(lds, Kb, Vb, ST, G, bid)); SEAM(2); }
    if (IN(3)) { if ((REPMASK >> 3) & 1) phase_r2(lds, Qb, Kb, Vb, Gb, ST, G, bid, H, 16383); phase_r2(lds, Qb, Kb, Vb, Gb, ST, G, bid, Gb, 0x7fffffff); SEAM(3); }
    if (IN(4)) { pg8::Gemm g{Gb, (const bf16_t*)(ws + WS_WROUT), MTOK, 1024, 2048, 2048, 2048, 1 << 20, 0}; S.init(MTOK, 1024, G, bid);
        EpiPlain E{H, LDH}; REP(4, pg8::gemm_phase(lds, g, S, E)); SEAM(4); }
    if (IN(5)) { phase_norm_res<false, true>(x, H, ng + 1 * DM, ng + 2 * DM, XB, H, gw, NGW, lane_id_fresh()); SEAM(5); }
    if (IN(6)) { pg8::Gemm g{H, (const bf16_t*)(ws + WS_WFIN), MTOK, 5632, 1024, LDH, LDW, 1 << 20, 0}; S.init(MTOK, 5632, G, bid);
        EpiSwiglu E{(bf16_t*)(ws + WS_HID0)}; REP(6, pg8::gemm_phase(lds, g, S, E, STAGGER_TICKS)); SEAM(6); }
    if (IN(7)) { pg8::Gemm g{(const bf16_t*)(ws + WS_HID0), (const bf16_t*)(ws + WS_WFOUT), MTOK, 1024, DFF, DFF, DFF, 1 << 20, 0}; S.init(MTOK, 1024, G, bid);
        EpiPlain E{H, LDH}; REP(7, pg8::gemm_phase(lds, g, S, E)); SEAM(7); }
    if (IN(8)) { phase_norm_res<true, true>(XB, H, ng + 3 * DM, ng + 4 * DM, XB, H, gw, NGW, lane_id_fresh()); SEAM(8); }
    if (IN(9)) { pg8::Gemm g{H, (const bf16_t*)(ws + WS_WLIN), MTOK, 3072, 1024, LDH, LDW, 1 << 20, 0}; S.init(MTOK, 3072, G, bid);
        EpiLruIn E{Y, U}; REP(9, pg8::gemm_phase(lds, g, S, E, STAGGER_TICKS)); SEAM(9); }
    if (IN(10)) { REP(10, phase_conv(U, conv_w, conv_b, UC, G, bid)); SEAM(10); }
    if (IN(11)) { pg8::Gemm g{UC, (const bf16_t*)(ws + WS_WG), MTOK, 3072, 256, LW, 256, 2, 512}; S.init(MTOK, 3072, G, bid);
        EpiGates E{UC, gate_b, a_param, LA, Bv}; REP(11, (pg8::gemm_phase<EpiGates, true, false>(lds, g, S, E))); SEAM(11); }
    if (IN(12)) { REP(12, phase_scan1(LA, Bv, Hc, Lc, G, bid)); SEAM(12); }
    if (IN(13)) { phase_scan2(LA, Bv, Hc, Lc, Y, G, bid); SEAM(13); }
    if (IN(14)) { pg8::Gemm g{Y, (const bf16_t*)(ws + WS_WLOUT), MTOK, 1024, LW, LW, LW, 1 << 20, 0}; S.init(MTOK, 1024, G, bid);
        EpiPlain E{H, LDH}; REP(14, pg8::gemm_phase(lds, g, S, E)); SEAM(14); }
    if (IN(15)) { phase_norm_res<true, true>(XB, H, ng + 5 * DM, ng + 6 * DM, XB, H, gw, NGW, lane_id_fresh()); SEAM(15); }
    if (IN(16)) { pg8::Gemm g{H, (const bf16_t*)(ws + WS_WFIN) + (size_t)5632 * LDW, MTOK, 5632, 1024, LDH, LDW, 1 << 20, 0}; S.init(MTOK, 5632, G, bid);
        EpiSwiglu E{(bf16_t*)(ws + WS_HID1)}; REP(16, pg8::gemm_phase(lds, g, S, E, STAGGER_TICKS)); SEAM(16); }
    if (IN(17)) { pg8::Gemm g{(const bf16_t*)(ws + WS_HID1), (const bf16_t*)(ws + WS_WFOUT) + (size_t)1024 * DFF, MTOK, 1024, DFF, DFF, DFF, 1 << 20, 0}; S.init(MTOK, 1024, G, bid);
        EpiPlain E{H, LDH}; REP(17, pg8::gemm_phase(lds, g, S, E)); SEAM(17); }
    if (IN(18)) { phase_norm_res<true, false>(XB, H, ng + 7 * DM, nullptr, a.out, H, gw, NGW, lane_id_fresh()); }
    if (((REPMASK >> 19) & 1) && a.coop) { for (int i = 0; i < 18; ++i) grid.sync(); }
#undef IN
#undef SEAM
}

extern "C" void kernel_launch(void* const* d_in, const int* in_sizes, int n_in, void* d_out, int out_size, void* d_ws, size_t ws_size, hipStream_t stream) {
    static int grid = 0;
    if (grid == 0) {
        if (n_in != 13 || out_size != MTOK * DM || ws_size < WS_NEED) { fprintf(stderr, "kernel_launch: unexpected shapes (n_in %d out %d ws %zu)\n", n_in, out_size, ws_size); grid = -1; return; }
        int dev = 0, cus = 0, per_cu = 0;
        hipGetDevice(&dev); hipDeviceGetAttribute(&cus, hipDeviceAttributeMultiprocessorCount, dev);
        hipFuncSetAttribute((const void*)fwd_megakernel, hipFuncAttributeMaxDynamicSharedMemorySize, LDS_BYTES);
        hipOccupancyMaxActiveBlocksPerMultiprocessor(&per_cu, (const void*)fwd_megakernel, 512, LDS_BYTES);
        if (per_cu < 1) { fprintf(stderr, "kernel_launch: occupancy query says %d blocks per CU\n", per_cu); per_cu = 1; }
        (void)hipGetLastError();
        grid = cus * per_cu;
    }
    if (grid < 0) return;
    Args a{};
    for (int i = 0; i < 13; ++i) a.in[i] = (const float*)d_in[i];
    a.out = (float*)d_out; a.ws = (unsigned char*)d_ws;
#if MK_MULTI
    for (int ph = 0; ph < NPHASE; ++ph) { a.ph_lo = ph; a.ph_hi = ph + 1; a.coop = 0;
        hipLaunchKernelGGL(fwd_megakernel, dim3(grid), dim3(512), LDS_BYTES, stream, a); }
#else
    a.ph_lo = 0; a.ph_hi = NPHASE; a.coop = 1;
    if (hipMemsetAsync((char*)d_ws + WS_SCAN, 0, 16384, stream) != hipSuccess) { fprintf(stderr, "kernel_launch: memset of the barrier words failed\n"); return; }
    void* args[] = {&a};
    hipError_t e = hipLaunchCooperativeKernel((const void*)fwd_megakernel, dim3(grid), dim3(512), args, LDS_BYTES, stream);
    if (e != hipSuccess) fprintf(stderr, "cooperative launch failed: %s (grid %d)\n", hipGetErrorString(e), grid);
#endif
}
```
